# Optimizing an MI355X kernel written in HIP

```python
import math
import jax, jax.numpy as jnp
from jax import lax
import numpy as np

D_MODEL = 2048
BATCH = 2
SEQ = 8192
DEPTH = 1

HEAD_DIM = 128
ROPE_FRAC_DIV = 4
ROPE_DIM = HEAD_DIM // ROPE_FRAC_DIV
ROPE_THETA = 500000.0
DSA_HEADS = 8
DSA_W = DSA_HEADS * HEAD_DIM
DSA_Q_RANK = 512
IDX_HEADS = 16
IDX_DIM = 64
IDX_ROPE_DIM = IDX_DIM // ROPE_FRAC_DIV
IDX_TOPK = 256
IDX_Q_BLOCK = 128
MOBA_HEADS = 8
MOBA_W = MOBA_HEADS * HEAD_DIM
MOBA_BLOCK = 256
MOBA_TOPK = 3
MOBA_Q_BLOCK = 32
MEM_LEN = 256
MEM_HEADS = 4
MEM_HEAD_DIM = 128
MEM_W = MEM_HEADS * MEM_HEAD_DIM
D_FF = 4 * D_MODEL
EPS = 1e-6
IN_SIZES = (DSA_Q_RANK, DSA_W, DSA_W, IDX_DIM, IDX_HEADS, MOBA_W, MOBA_W, MOBA_W, D_MODEL, D_MODEL)
IN_COLS = DSA_Q_RANK + 2 * DSA_W + IDX_DIM + IDX_HEADS + 3 * MOBA_W + 2 * D_MODEL

kernel_name = "hybrid_dsa_moba_gated_block"


def _split_points():
    pts, acc = [], 0
    for s in IN_SIZES[:-1]:
        acc += s
        pts.append(acc)
    return pts


def rmsnorm(x, g):
    x32 = x.astype(jnp.float32)
    y = x32 * lax.rsqrt(jnp.mean(x32 * x32, axis=-1, keepdims=True) + EPS)
    return (y * g.astype(jnp.float32)).astype(x.dtype)


def rope_partial(x, pos, rot_dim):
    half = rot_dim // 2
    inv = ROPE_THETA ** (-jnp.arange(half, dtype=jnp.float32) * (2.0 / rot_dim))
    ang = pos.astype(jnp.float32)[..., None] * inv
    cos = jnp.cos(ang)[:, :, None, :]
    sin = jnp.sin(ang)[:, :, None, :]
    xr = x[..., :rot_dim].astype(jnp.float32)
    x1, x2 = xr[..., :half], xr[..., half:]
    rot = jnp.concatenate([x1 * cos - x2 * sin, x2 * cos + x1 * sin], axis=-1).astype(x.dtype)
    return jnp.concatenate([rot, x[..., rot_dim:]], axis=-1)


def dsa_branch(c_q, k, v, k_idx, w_idx, g_cq, w_uq, w_iq, pos):
    B, S, _ = k.shape
    c_q = rmsnorm(c_q, g_cq)
    q = rope_partial((c_q @ w_uq).reshape(B, S, DSA_HEADS, HEAD_DIM), pos, ROPE_DIM)
    q_idx = rope_partial((c_q @ w_iq).reshape(B, S, IDX_HEADS, IDX_DIM), pos, IDX_ROPE_DIM)
    k = rope_partial(k.reshape(B, S, DSA_HEADS, HEAD_DIM), pos, ROPE_DIM)
    v = v.reshape(B, S, DSA_HEADS, HEAD_DIM)
    k_idx = rope_partial(k_idx[:, :, None, :], pos, IDX_ROPE_DIM)[:, :, 0, :]
    w_idx = w_idx.astype(jnp.float32) * (IDX_HEADS ** -0.5 * IDX_DIM ** -0.5)
    n_sel = min(IDX_TOPK, S // 4)
    n_blocks = S // IDX_Q_BLOCK
    key_pos = jnp.arange(S)
    scale = HEAD_DIM ** -0.5

    def block(i):
        start = i * IDX_Q_BLOCK
        qb = lax.dynamic_slice_in_dim(q, start, IDX_Q_BLOCK, axis=1)
        qib = lax.dynamic_slice_in_dim(q_idx, start, IDX_Q_BLOCK, axis=1)
        wb = lax.dynamic_slice_in_dim(w_idx, start, IDX_Q_BLOCK, axis=1)
        t = start + jnp.arange(IDX_Q_BLOCK)
        logits = jnp.einsum('bqhd,bsd->bqhs', qib, k_idx).astype(jnp.float32)
        score = jnp.einsum('bqh,bqhs->bqs', wb, jax.nn.relu(logits))
        causal = key_pos[None, :] <= t[:, None]
        score = jnp.where(causal[None], score, -jnp.inf)
        _, sel = lax.top_k(score, n_sel)
        valid = sel <= t[None, :, None]
        kg = jax.vmap(lambda kk, ii: kk[ii])(k, sel)
        vg = jax.vmap(lambda vv, ii: vv[ii])(v, sel)
        s = jnp.einsum('bqhd,bqnhd->bhqn', qb, kg).astype(jnp.float32) * scale
        s = jnp.where(valid[:, None], s, -jnp.inf)
        p = jax.nn.softmax(s, axis=-1).astype(v.dtype)
        o = jnp.einsum('bhqn,bqnhd->bqhd', p, vg)
        return o.reshape(B, IDX_Q_BLOCK, DSA_W)

    out = lax.map(block, jnp.arange(n_blocks))
    return out.transpose(1, 0, 2, 3).reshape(B, S, DSA_W)


def moba_branch(q, k, v, pos):
    B, S, _ = q.shape
    q = rope_partial(q.reshape(B, S, MOBA_HEADS, HEAD_DIM), pos, ROPE_DIM)
    k = rope_partial(k.reshape(B, S, MOBA_HEADS, HEAD_DIM), pos, ROPE_DIM)
    v = v.reshape(B, S, MOBA_HEADS, HEAD_DIM)
    nb = -(-S // MOBA_BLOCK)
    pad = nb * MOBA_BLOCK - S
    kp = jnp.pad(k, ((0, 0), (0, pad), (0, 0), (0, 0)))
    vp = jnp.pad(v, ((0, 0), (0, pad), (0, 0), (0, 0)))
    kblk = kp.reshape(B, nb, MOBA_BLOCK, MOBA_HEADS, HEAD_DIM)
    vblk = vp.reshape(B, nb, MOBA_BLOCK, MOBA_HEADS, HEAD_DIM)
    kmean = jnp.mean(kblk.astype(jnp.float32), axis=2).astype(k.dtype)
    kbh = kblk.transpose(0, 3, 1, 2, 4)
    vbh = vblk.transpose(0, 3, 1, 2, 4)
    n_sel = min(MOBA_TOPK, nb - 1)
    n_qblocks = S // MOBA_Q_BLOCK
    scale = HEAD_DIM ** -0.5
    gather2 = jax.vmap(jax.vmap(lambda kk, ii: kk[ii]))

    def block(i):
        start = i * MOBA_Q_BLOCK
        qb = lax.dynamic_slice_in_dim(q, start, MOBA_Q_BLOCK, axis=1)
        t = start + jnp.arange(MOBA_Q_BLOCK)
        cur = start // MOBA_BLOCK
        own_k = lax.dynamic_slice_in_dim(kp, cur * MOBA_BLOCK, MOBA_BLOCK, axis=1)
        own_v = lax.dynamic_slice_in_dim(vp, cur * MOBA_BLOCK, MOBA_BLOCK, axis=1)
        own_pos = cur * MOBA_BLOCK + jnp.arange(MOBA_BLOCK)
        s_own = jnp.einsum('bqhd,bkhd->bhqk', qb, own_k).astype(jnp.float32) * scale
        s_own = jnp.where((own_pos[None, :] <= t[:, None])[None, None], s_own, -jnp.inf)
        if n_sel > 0:
            gate = jnp.einsum('bqhd,bnhd->bhqn', qb, kmean).astype(jnp.float32)
            gate = jnp.where(jnp.arange(nb) < cur, gate, -jnp.inf)
            _, sel = lax.top_k(gate, n_sel)
            valid = sel < cur
            kg = gather2(kbh, sel)
            vg = gather2(vbh, sel)
            qbh = qb.transpose(0, 2, 1, 3)
            s_sel = jnp.einsum('bhqd,bhqnkd->bhqnk', qbh, kg).astype(jnp.float32) * scale
            s_sel = jnp.where(valid[..., None], s_sel, -jnp.inf)
            s_sel = s_sel.reshape(B, MOBA_HEADS, MOBA_Q_BLOCK, n_sel * MOBA_BLOCK)
            p = jax.nn.softmax(jnp.concatenate([s_sel, s_own], axis=-1), axis=-1).astype(v.dtype)
            p_sel = p[..., :n_sel * MOBA_BLOCK].reshape(B, MOBA_HEADS, MOBA_Q_BLOCK, n_sel, MOBA_BLOCK)
            p_own = p[..., n_sel * MOBA_BLOCK:]
            o = (jnp.einsum('bhqnk,bhqnkd->bqhd', p_sel, vg)
                 + jnp.einsum('bhqk,bkhd->bqhd', p_own, own_v))
        else:
            p_own = jax.nn.softmax(s_own, axis=-1).astype(v.dtype)
            o = jnp.einsum('bhqk,bkhd->bqhd', p_own, own_v)
        return o.reshape(B, MOBA_Q_BLOCK, MOBA_W)

    out = lax.map(block, jnp.arange(n_qblocks))
    return out.transpose(1, 0, 2, 3).reshape(B, S, MOBA_W)


def mem_cross_attn(h, mem_n, w_q, w_kv, w_o):
    B, S, _ = h.shape
    M = mem_n.shape[1]
    q = (h @ w_q).reshape(B, S, MEM_HEADS, MEM_HEAD_DIM)
    kv = mem_n @ w_kv
    k = kv[..., :MEM_W].reshape(B, M, MEM_HEADS, MEM_HEAD_DIM)
    v = kv[..., MEM_W:].reshape(B, M, MEM_HEADS, MEM_HEAD_DIM)
    s = jnp.einsum('bshd,bmhd->bhsm', q, k).astype(jnp.float32) * (MEM_HEAD_DIM ** -0.5)
    p = jax.nn.softmax(s, axis=-1).astype(v.dtype)
    o = jnp.einsum('bhsm,bmhd->bshd', p, v).reshape(B, S, MEM_W)
    return o @ w_o


def setup_inputs(seed: int = 0) -> dict:
    key = jax.random.key(seed)
    ks = jax.random.split(key, 24)

    def dense(k, shape, fan_in):
        return jax.random.normal(k, shape, jnp.float32) * (fan_in ** -0.5)

    def gain(k, shape):
        return 1.0 + 0.02 * jax.random.normal(k, shape, jnp.float32)

    x = jax.random.normal(ks[0], (BATCH, SEQ, D_MODEL), jnp.float32)
    mem = jax.random.normal(ks[1], (BATCH, MEM_LEN, D_MODEL), jnp.float32)
    offsets = jax.random.randint(ks[2], (BATCH, 1), 0, 1024, jnp.int32)
    positions = (offsets + jnp.arange(SEQ, dtype=jnp.int32)[None, :]).astype(jnp.int32)
    L = DEPTH
    return {
        "x": x,
        "mem": mem,
        "positions": positions,
        "g_mix": gain(ks[3], (L, D_MODEL)),
        "w_in": dense(ks[4], (L, D_MODEL, IN_COLS), D_MODEL),
        "g_cq": gain(ks[5], (L, DSA_Q_RANK)),
        "w_uq": dense(ks[6], (L, DSA_Q_RANK, DSA_W), DSA_Q_RANK),
        "w_iq": dense(ks[7], (L, DSA_Q_RANK, IDX_HEADS * IDX_DIM), DSA_Q_RANK),
        "w_dsa_o": dense(ks[8], (L, DSA_W, D_MODEL), DSA_W),
        "w_moba_o": dense(ks[9], (L, MOBA_W, D_MODEL), MOBA_W),
        "w_out": dense(ks[10], (L, D_MODEL, D_MODEL), D_MODEL),
        "g_mem_q": gain(ks[11], (L, D_MODEL)),
        "g_mem_kv": gain(ks[12], (L, D_MODEL)),
        "w_mem_q": dense(ks[13], (L, D_MODEL, MEM_W), D_MODEL),
        "w_mem_kv": dense(ks[14], (L, D_MODEL, 2 * MEM_W), D_MODEL),
        "w_mem_o": dense(ks[15], (L, MEM_W, D_MODEL), MEM_W),
        "g_ff": gain(ks[16], (L, D_MODEL)),
        "w_ff1": dense(ks[17], (L, D_MODEL, D_FF), D_MODEL),
        "w_ff2": dense(ks[18], (L, D_FF, D_MODEL), D_FF),
        "g_final": gain(ks[19], (D_MODEL,)),
    }


def reference(x, mem, positions, g_mix, w_in, g_cq, w_uq, w_iq, w_dsa_o, w_moba_o, w_out,
              g_mem_q, g_mem_kv, w_mem_q, w_mem_kv, w_mem_o, g_ff, w_ff1, w_ff2, g_final):
    pts = _split_points()
    for l in range(DEPTH):
        h = rmsnorm(x, g_mix[l])
        proj = h @ w_in[l]
        c_q, k_a, v_a, k_idx, w_idx, q_b, k_b, v_b, gl_a, gl_b = jnp.split(proj, pts, axis=-1)
        y_a = dsa_branch(c_q, k_a, v_a, k_idx, w_idx, g_cq[l], w_uq[l], w_iq[l], positions) @ w_dsa_o[l]
        y_b = moba_branch(q_b, k_b, v_b, positions) @ w_moba_o[l]
        merged = jax.nn.sigmoid(gl_a) * y_a + jax.nn.sigmoid(gl_b) * y_b
        x = x + merged @ w_out[l]
        hm = rmsnorm(x, g_mem_q[l])
        mem_n = rmsnorm(mem, g_mem_kv[l])
        x = x + mem_cross_attn(hm, mem_n, w_mem_q[l], w_mem_kv[l], w_mem_o[l])
        hf = rmsnorm(x, g_ff[l])
        x = x + jnp.square(jax.nn.relu(hf @ w_ff1[l])) @ w_ff2[l]
    return rmsnorm(x, g_final)
```

```cpp
#include <hip/hip_runtime.h>
#include <hip/hip_cooperative_groups.h>
#include <cstdio>
#include <cstdint>
namespace cg = cooperative_groups;
#ifndef ONE_LAUNCH
#define ONE_LAUNCH 1
#endif
namespace pg8 {
#define PG8_LAS __attribute__((address_space(3)))
typedef unsigned short bf16_t;
typedef short bf16x8 __attribute__((ext_vector_type(8)));
typedef float f32x4 __attribute__((ext_vector_type(4)));
typedef unsigned u32x4 __attribute__((ext_vector_type(4)));
constexpr int BM = 256, BK = 64, HALF = 128, HTB = HALF * BK * 2  , STAGE_BYTES = 8 * HTB, NXCD = 8, WGM = 8;

__host__ __device__ __forceinline__ int lds_byte(int r, int c) { const int st = (r >> 4) * 2 + (c >> 5), rr = r & 15, cc = c & 31, ob = rr * 64 + cc * 2; return st * 1024 + (ob ^ (((ob >> 9) & 1) << 5)); }
__host__ __device__ __forceinline__ void stage_rc(int b, int& R, int& C) { const int st = b / 1024, sb = b % 1024, swz = sb ^ (((sb >> 9) & 1) << 5); R = (st >> 1) * 16 + swz / 64; C = (st & 1) * 32 + (swz % 64) / 2; }
__host__ __device__ __forceinline__ int perm32(int rho) { const int n = rho >> 4, i = rho & 15; return 8 * (i >> 2) + 4 * n + (i & 3); }

struct Unit { int pm, pn; };
struct Gemm { const bf16_t* A; const bf16_t* Bt; int M, N, K; };

struct StaticOrder {
    int nM, nN, nwg, G, c;
    __host__ __device__ void init(int M, int N, int G_, int c_) { nM = M / BM; nN = N / BM; nwg = nM * nN; G = G_; c = c_; }
    __host__ __device__ bool next(int i, Unit& u) const {
        const long L = (long)i * G + c; if (L >= nwg) return false;
        int wgid = (int)L; { const int q = nwg / NXCD, r = nwg % NXCD, xcd = wgid % NXCD, off = wgid / NXCD; wgid = (xcd < r ? xcd * (q + 1) : r * (q + 1) + (xcd - r) * q) + off; }
        const int nig = WGM * nN, gid = wgid / nig, fm = gid * WGM, gsz = (nM - fm) < WGM ? (nM - fm) : WGM;
        u.pm = fm + ((wgid % nig) % gsz); u.pn = (wgid % nig) / gsz; return true;
    }
    __device__ __forceinline__ void a_ready(const Unit&) const {}
    __device__ __forceinline__ void done(const Unit&) const {}
};
__device__ __forceinline__ unsigned cvt_pk_bf16(float lo, float hi) { unsigned r; asm volatile("v_cvt_pk_bf16_f32 %0, %1, %2" : "=v"(r) : "v"(lo), "v"(hi)); return r; }
template <class Epi, class Sched, bool ALIGN_EPI = false, bool SP2 = false>
__device__ __forceinline__ void gemm_phase(PG8_LAS unsigned char* lds, const Gemm g, const Sched& S, const Epi& E) {
    const int tid = threadIdx.x, wid = __builtin_amdgcn_readfirstlane(tid >> 6), lane = tid & 63, wr = wid >> 2, wc = wid & 3, fr = lane & 15, fq = lane >> 4;
    const int K = g.K, nt = K / BK;
    unsigned voffA[2], voffB[2];
#pragma unroll
    for (int i = 0; i < 2; ++i) { int R, C; stage_rc(tid * 16 + i * 8192, R, C); const int Rb = Epi::PERM ? ((R & ~31) + perm32(R & 31)) : R;
        voffA[i] = (unsigned)(R * K + C) * 2u; voffB[i] = (unsigned)(Rb * K + C) * 2u; }
    const size_t kstep = (size_t)(BK * 2);
    const size_t hstep = (size_t)HALF * K * 2;
    const size_t tstep = 2 * hstep;
    const unsigned ldsw = (unsigned)wid * 1024u;
    const int aoff = lds_byte(wr * 64 + fr, fq * 8), boff = lds_byte(wc * 32 + fr, fq * 8);
#define PG8_SA(b, h) (((b) * 2 + (h)) * HTB)
#define PG8_SB(b, h) ((4 + (b) * 2 + (h)) * HTB)
#define PG8_STAGE(bufoff, gbase, voff) do { _Pragma("unroll") for (int _i = 0; _i < 2; ++_i) \
        __builtin_amdgcn_global_load_lds((const unsigned*)((const char*)(gbase) + (voff)[_i]), (PG8_LAS unsigned*)(lds + (bufoff) + ldsw + _i * 8192), 16, 0, 0); } while (0)
#define PG8_LDA(dst, b, h) do { _Pragma("unroll") for (int m = 0; m < 4; ++m) _Pragma("unroll") for (int k = 0; k < 2; ++k) dst[m][k] = *(const PG8_LAS bf16x8*)(lds + PG8_SA(b, h) + aoff + m * 2048 + k * 1024); } while (0)
#define PG8_LDB(dst, b, h) do { _Pragma("unroll") for (int n = 0; n < 2; ++n) _Pragma("unroll") for (int k = 0; k < 2; ++k) dst[n][k] = *(const PG8_LAS bf16x8*)(lds + PG8_SB(b, h) + boff + n * 2048 + k * 1024); } while (0)
#define PG8_MMA(ai, bj, At, Bt) do { __builtin_amdgcn_s_setprio(1); _Pragma("unroll") for (int m = 0; m < 4; ++m) _Pragma("unroll") for (int n = 0; n < 2; ++n) _Pragma("unroll") for (int k = 0; k < 2; ++k) \
        acc[ai][bj][m][n] = __builtin_amdgcn_mfma_f32_16x16x32_bf16(Bt[n][k], At[m][k], acc[ai][bj][m][n], 0, 0, 0); __builtin_amdgcn_s_setprio(0); } while (0)
#define PG8_WAIT_V(n) asm volatile("s_waitcnt vmcnt(" #n ")" ::: "memory")
#define PG8_WAIT_L(n) asm volatile("s_waitcnt lgkmcnt(" #n ")" ::: "memory")
#define PG8_BAR __builtin_amdgcn_s_barrier()
#define PG8_SCHED __builtin_amdgcn_sched_barrier(0)
    Unit cur, nxt; int ui = 0;
    if (!S.next(0, cur)) return;
    f32x4 acc[2][2][4][2];
#pragma unroll
    for (int a = 0; a < 2; ++a)
#pragma unroll
        for (int b = 0; b < 2; ++b)
#pragma unroll
            for (int m = 0; m < 4; ++m)
#pragma unroll
                for (int n = 0; n < 2; ++n) acc[a][b][m][n] = (f32x4){0.f, 0.f, 0.f, 0.f};
    bf16x8 At[4][2], B0[2][2], B1[2][2];
    const char* cA = (const char*)g.A + (size_t)cur.pm * tstep; const char* cB = (const char*)g.Bt + (size_t)cur.pn * tstep;
    S.a_ready(cur);
    if constexpr (SP2) {
        PG8_STAGE(PG8_SB(0, 0), cB, voffB); PG8_STAGE(PG8_SB(0, 1), cB + hstep, voffB); PG8_STAGE(PG8_SA(0, 0), cA, voffA); PG8_STAGE(PG8_SA(0, 1), cA + hstep, voffA);
        if (wr == 1) PG8_BAR;
        PG8_WAIT_V(2); PG8_BAR;
        PG8_STAGE(PG8_SB(1, 0), cB + kstep, voffB); PG8_STAGE(PG8_SA(1, 0), cA + kstep, voffA); PG8_STAGE(PG8_SB(1, 1), cB + hstep + kstep, voffB);
        PG8_WAIT_V(6); PG8_BAR;
    } else {
        PG8_STAGE(PG8_SB(0, 0), cB, voffB); PG8_STAGE(PG8_SA(0, 0), cA, voffA); PG8_STAGE(PG8_SB(0, 1), cB + hstep, voffB); PG8_STAGE(PG8_SA(0, 1), cA + hstep, voffA);
        if (wr == 1) PG8_BAR;
        PG8_WAIT_V(4); PG8_BAR;
        PG8_STAGE(PG8_SB(1, 0), cB + kstep, voffB); PG8_STAGE(PG8_SA(1, 0), cA + kstep, voffA); PG8_STAGE(PG8_SB(1, 1), cB + hstep + kstep, voffB);
        PG8_WAIT_V(6); PG8_BAR;
    }
    for (;;) {
        const bool has_next = S.next(ui + 1, nxt);
        const char* nA = has_next ? (const char*)g.A + (size_t)nxt.pm * tstep : cA; const char* nB = has_next ? (const char*)g.Bt + (size_t)nxt.pn * tstep : cB;
        for (int t = 0; t < nt; t += 2) {
            const bool last = (t == nt - 2);
            const char* a1 = cA + (size_t)(t + 1) * kstep;
            const char* a2 = last ? nA : cA + (size_t)(t + 2) * kstep; const char* b2 = last ? nB : cB + (size_t)(t + 2) * kstep;
            const char* a3 = a2 + kstep; const char* b3 = b2 + kstep;
            if (last && has_next) S.a_ready(nxt);
            if constexpr (SP2) {
            PG8_LDB(B0, 0, 0); PG8_LDB(B1, 0, 1); PG8_SCHED; PG8_LDA(At, 0, 0); PG8_STAGE(PG8_SA(1, 1), a1 + hstep, voffA);
            PG8_WAIT_V(8); PG8_WAIT_L(0); PG8_BAR; PG8_MMA(0, 0, At, B0); PG8_MMA(0, 1, At, B1); PG8_BAR; PG8_SCHED;
            PG8_LDA(At, 0, 1); PG8_STAGE(PG8_SB(0, 0), b2, voffB); PG8_STAGE(PG8_SB(0, 1), b2 + hstep, voffB); PG8_STAGE(PG8_SA(0, 0), a2, voffA);
            PG8_WAIT_V(8); PG8_WAIT_L(0); PG8_BAR; PG8_MMA(1, 0, At, B0); PG8_MMA(1, 1, At, B1); PG8_BAR; PG8_SCHED;
            PG8_LDB(B0, 1, 0); PG8_LDB(B1, 1, 1); PG8_SCHED; PG8_LDA(At, 1, 0); PG8_STAGE(PG8_SA(0, 1), a2 + hstep, voffA);
            PG8_WAIT_V(8); PG8_WAIT_L(0); PG8_BAR; PG8_MMA(0, 0, At, B0); PG8_MMA(0, 1, At, B1); PG8_BAR; PG8_SCHED;
            PG8_LDA(At, 1, 1); PG8_STAGE(PG8_SB(1, 0), b3, voffB); PG8_STAGE(PG8_SB(1, 1), b3 + hstep, voffB); PG8_STAGE(PG8_SA(1, 0), a3, voffA);
            PG8_WAIT_V(8); PG8_WAIT_L(0); PG8_BAR; PG8_MMA(1, 0, At, B0); PG8_MMA(1, 1, At, B1); PG8_BAR; PG8_SCHED;
            } else {
            PG8_LDB(B0, 0, 0); PG8_SCHED; PG8_LDA(At, 0, 0); PG8_STAGE(PG8_SA(1, 1), a1 + hstep, voffA);
            PG8_WAIT_L(8); PG8_BAR; PG8_WAIT_L(0); PG8_MMA(0, 0, At, B0); PG8_BAR; PG8_SCHED;
            PG8_LDB(B1, 0, 1); PG8_STAGE(PG8_SB(0, 0), b2, voffB);
            PG8_BAR; PG8_WAIT_L(0); PG8_MMA(0, 1, At, B1); PG8_BAR;
            PG8_LDA(At, 0, 1); PG8_STAGE(PG8_SA(0, 0), a2, voffA);
            PG8_BAR; PG8_WAIT_L(0); PG8_MMA(1, 0, At, B0); PG8_BAR; PG8_SCHED;
            PG8_STAGE(PG8_SB(0, 1), b2 + hstep, voffB);
            PG8_WAIT_V(6); PG8_BAR; PG8_MMA(1, 1, At, B1); PG8_BAR;
            PG8_LDB(B0, 1, 0); PG8_SCHED; PG8_LDA(At, 1, 0); PG8_STAGE(PG8_SA(0, 1), a2 + hstep, voffA);
            PG8_WAIT_L(8); PG8_BAR; PG8_WAIT_L(0); PG8_MMA(0, 0, At, B0); PG8_BAR; PG8_SCHED;
            PG8_LDB(B1, 1, 1); PG8_STAGE(PG8_SB(1, 0), b3, voffB);
            PG8_BAR; PG8_WAIT_L(0); PG8_MMA(0, 1, At, B1); PG8_BAR;
            PG8_LDA(At, 1, 1); PG8_STAGE(PG8_SA(1, 0), a3, voffA);
            PG8_BAR; PG8_WAIT_L(0); PG8_MMA(1, 0, At, B0); PG8_BAR; PG8_SCHED;
            PG8_STAGE(PG8_SB(1, 1), b3 + hstep, voffB);
            PG8_WAIT_V(6); PG8_BAR; PG8_MMA(1, 1, At, B1); PG8_BAR;
            }
        }
        if constexpr (ALIGN_EPI) { if (wr == 0) PG8_BAR; }
        if constexpr (!Epi::AFTER_DRAIN) { E(acc, cur, wr, wc, fr, fq); S.done(cur); }
        if (!has_next) break;
#pragma unroll
        for (int a = 0; a < 2; ++a)
#pragma unroll
            for (int b = 0; b < 2; ++b)
#pragma unroll
                for (int m = 0; m < 4; ++m)
#pragma unroll
                    for (int n = 0; n < 2; ++n) acc[a][b][m][n] = (f32x4){0.f, 0.f, 0.f, 0.f};
        cur = nxt; cA = nA; cB = nB; ++ui;
        if constexpr (ALIGN_EPI) { if (wr == 1) PG8_BAR; }
    }
    PG8_WAIT_V(0);
    if constexpr (!ALIGN_EPI) { if (wr == 0) PG8_BAR; }
    PG8_BAR;
    if constexpr (Epi::AFTER_DRAIN) { E.fused(acc, cur, wr, wc, fr, fq, lds, wid, lane); S.done(cur); }
#undef PG8_SA
#undef PG8_SB
#undef PG8_STAGE
#undef PG8_LDA
#undef PG8_LDB
#undef PG8_MMA
#undef PG8_WAIT_V
#undef PG8_WAIT_L
#undef PG8_BAR
#undef PG8_SCHED
}
}

#define GAS __attribute__((address_space(1)))
#define LAS __attribute__((address_space(3)))
typedef unsigned short bf16;
typedef unsigned v4u __attribute__((ext_vector_type(4)));
typedef unsigned v2u __attribute__((ext_vector_type(2)));
typedef float f32x4 __attribute__((ext_vector_type(4)));
typedef float f32x2 __attribute__((ext_vector_type(2)));
typedef short bf16x8 __attribute__((ext_vector_type(8)));
using pg8::Unit;
typedef __bf16 bf16x2_t __attribute__((ext_vector_type(2)));
__device__ __forceinline__ unsigned cvt_pk_bf16(float lo, float hi) { f32x2 v = {lo, hi}; bf16x2_t b = __builtin_convertvector(v, bf16x2_t); return __builtin_bit_cast(unsigned, b); }
#define LDS_WAIT() asm volatile("s_waitcnt lgkmcnt(0)" ::: "memory")

constexpr int BATCH = 2, SEQ = 8192, T = BATCH * SEQ, DM = 2048, NIN = 9984, DFF = 8192;
constexpr float EPS = 1e-6f;
constexpr float LOG2E = 1.4426950408889634f;
constexpr float QSCALE = 0.08838834764831845f * LOG2E;
constexpr int NWAVES = 8;
constexpr int LDS_BYTES = 147456;
constexpr int NPH = 14;

constexpr size_t MiB = 1u << 20;
constexpr size_t WS_BAR = 0, WS_SSQ1 = 65536, WS_SSQ2 = 131072, WS_SSQ3 = 196608, WS_KMEAN = 262144;
constexpr size_t WS_WQ = 1 * MiB, WS_WDSAO = 3 * MiB, WS_WMOBAO = 7 * MiB, WS_WOUT = 11 * MiB, WS_WMQ = 19 * MiB, WS_WMKV = 21 * MiB, WS_WMO = 25 * MiB, WS_MEMKV = 27 * MiB, WS_MEMN = 28 * MiB;
constexpr size_t WS_H = 30 * MiB, WS_QA = 30 * MiB, WS_ODSA = WS_QA  , WS_QIDX = 62 * MiB;
constexpr size_t WS_FF1 = 30 * MiB, WS_FF2A = 62 * MiB, WS_FF2B = 78 * MiB;
constexpr size_t WS_WIN = 94 * MiB, WS_CQ = 133 * MiB, WS_ROPE32 = 149 * MiB, WS_ROPE16 = 151 * MiB, WS_KIDX = 152 * MiB, WS_WIDX = 154 * MiB, WS_SSQ0 = 155 * MiB;
constexpr size_t WS_SCR = 156 * MiB, WS_SELG = 94 * MiB;
constexpr size_t WS_KA = 220 * MiB, WS_VA = 252 * MiB, WS_MERGED = 220 * MiB;
constexpr size_t WS_QB = 284 * MiB, WS_OMOBA = WS_QB  , WS_KB = 316 * MiB, WS_VB = 348 * MiB;
constexpr size_t WS_XB = 284 * MiB, WS_QM = 348 * MiB, WS_OM = 364 * MiB;
constexpr size_t WS_SGA = 380 * MiB, WS_SGB = 444 * MiB, WS_XRES = 380 * MiB;
constexpr size_t WS_UA = 94 * MiB, WS_END = 512 * MiB;

__device__ __forceinline__ float wave_sum(float v) {
#pragma unroll
    for (int o = 1; o < 64; o <<= 1) v += __shfl_xor(v, o);
    return v;
}
__device__ __forceinline__ int wave_sum_i(int v) {
#pragma unroll
    for (int o = 1; o < 64; o <<= 1) v += __shfl_xor(v, o);
    return v;
}
__device__ __forceinline__ float bflo(unsigned u) { return __builtin_bit_cast(float, u << 16); }
__device__ __forceinline__ float bfhi(unsigned u) { return __builtin_bit_cast(float, u & 0xffff0000u); }
__device__ __forceinline__ float fexp2(float x) { return __builtin_amdgcn_exp2f(x); }

typedef const pg8::f32x4 (&AccRef)[2][2][4][2];

typedef _Float16 h2_t __attribute__((ext_vector_type(2)));
__device__ __forceinline__ unsigned cvt_pk_f16(float lo, float hi) { f32x2 v = {lo, hi}; h2_t h = __builtin_convertvector(v, h2_t); return __builtin_bit_cast(unsigned, h); }
__device__ __forceinline__ v4u pack8h(const float* v) { v4u w; w.x = cvt_pk_f16(v[0], v[1]); w.y = cvt_pk_f16(v[2], v[3]); w.z = cvt_pk_f16(v[4], v[5]); w.w = cvt_pk_f16(v[6], v[7]); return w; }
__device__ __forceinline__ float hdot2(unsigned a, unsigned b, float c) { return __builtin_amdgcn_fdot2(__builtin_bit_cast(h2_t, a), __builtin_bit_cast(h2_t, b), c, false); }
__device__ __forceinline__ v4u pack8(const float* v) { v4u w; w.x = cvt_pk_bf16(v[0], v[1]); w.y = cvt_pk_bf16(v[2], v[3]); w.z = cvt_pk_bf16(v[4], v[5]); w.w = cvt_pk_bf16(v[6], v[7]); return w; }

__device__ __forceinline__ void rope_head128(float* v, const f32x2* cs  , int fq) {
#pragma unroll
    for (int e = 0; e < 8; ++e) { const float o = __shfl_xor(v[e], 32); const f32x2 c = cs[e]; v[e] = v[e] * c.x + (fq < 2 ? -o : o) * c.y; }
}
__device__ __forceinline__ void rope_head64(float* v, const f32x2* cs  , int fq) {
#pragma unroll
    for (int e = 0; e < 8; ++e) { const float o = __shfl_xor(v[e], 16); const f32x2 c = cs[e]; const float r = v[e] * c.x + (fq == 0 ? -o : o) * c.y; if (fq < 2) v[e] = r; }
}

struct EpiIn {
    static constexpr bool PERM = true, AFTER_DRAIN = false;
    bf16 *cq, *ka, *va, *qb, *kb, *vb, *sga, *sgb, *kidx; float* widx; float* ssq0; const f32x2* rope32; const f32x2* rope16;
    __device__ __forceinline__ void operator()(AccRef acc, const Unit& u, int wr, int wc, int fr, int fq) const {
        const int pn = u.pn, row0 = u.pm * 256 + wr * 64 + fr, cl = wc * 32 + 8 * fq;
        if (pn < 2) {
#pragma unroll
            for (int ai = 0; ai < 2; ++ai)
#pragma unroll
                for (int m = 0; m < 4; ++m) { const int row = row0 + ai * 128 + m * 16; float ss = 0.f;
#pragma unroll
                    for (int bj = 0; bj < 2; ++bj) { float v[8];
#pragma unroll
                        for (int e = 0; e < 8; ++e) { v[e] = acc[ai][bj][m][e >> 2][e & 3]; ss += v[e] * v[e]; }
                        *(v4u*)(cq + (size_t)row * 512 + pn * 256 + bj * 128 + cl) = pack8(v); }
                    ss += __shfl_xor(ss, 16); ss += __shfl_xor(ss, 32);
                    if (fq == 0) ssq0[(size_t)row * 8 + pn * 4 + wc] = ss; }
        } else if (pn < 22) {
            const int sec = (pn - 2) >> 2, colb = ((pn - 2) & 3) * 256;
            bf16* base = sec == 0 ? ka : sec == 1 ? va : sec == 2 ? qb : sec == 3 ? kb : vb;
            const bool rope = (sec != 1 && sec != 4) && (wc == 0);
            const float sc = sec == 2 ? QSCALE : 1.f;
#pragma unroll
            for (int ai = 0; ai < 2; ++ai)
#pragma unroll
                for (int m = 0; m < 4; ++m) { const int row = row0 + ai * 128 + m * 16;
#pragma unroll
                    for (int bj = 0; bj < 2; ++bj) { float v[8];
#pragma unroll
                        for (int e = 0; e < 8; ++e) v[e] = acc[ai][bj][m][e >> 2][e & 3];
                        if (rope) rope_head128(v, rope32 + (size_t)row * 16 + 8 * (fq & 1), fq);
#pragma unroll
                        for (int e = 0; e < 8; ++e) v[e] *= sc;
                        *(v4u*)(base + (size_t)row * 1024 + colb + bj * 128 + cl) = sec < 2 ? pack8h(v) : pack8(v); } }
        } else if (pn < 38) {
            const int g = pn - 22; bf16* base = g < 8 ? sga : sgb; const int colb = (g & 7) * 256;
#pragma unroll
            for (int ai = 0; ai < 2; ++ai)
#pragma unroll
                for (int m = 0; m < 4; ++m) { const int row = row0 + ai * 128 + m * 16;
#pragma unroll
                    for (int bj = 0; bj < 2; ++bj) { float v[8];
#pragma unroll
                        for (int e = 0; e < 8; ++e) { const float x = acc[ai][bj][m][e >> 2][e & 3]; v[e] = __builtin_amdgcn_rcpf(1.f + fexp2(-LOG2E * x)); }
                        *(v4u*)(base + (size_t)row * 2048 + colb + bj * 128 + cl) = pack8(v); } }
        } else {
            if (wc < 2) {
#pragma unroll
                for (int ai = 0; ai < 2; ++ai)
#pragma unroll
                    for (int m = 0; m < 4; ++m) { const int row = row0 + ai * 128 + m * 16; float v[8];
#pragma unroll
                        for (int e = 0; e < 8; ++e) v[e] = acc[ai][0][m][e >> 2][e & 3];
                        if (wc == 0) rope_head64(v, rope16 + (size_t)row * 8, fq);
                        *(v4u*)(kidx + (size_t)row * 64 + cl) = pack8(v); }
            } else if (wc == 2 && fq < 2) {
#pragma unroll
                for (int ai = 0; ai < 2; ++ai)
#pragma unroll
                    for (int m = 0; m < 4; ++m) { const int row = row0 + ai * 128 + m * 16;
                        *(f32x4*)(widx + (size_t)row * 16 + 8 * fq) = acc[ai][0][m][0] * 0.03125f;
                        *(f32x4*)(widx + (size_t)row * 16 + 8 * fq + 4) = acc[ai][0][m][1] * 0.03125f; }
            }
        }
    }
};

struct EpiQ {
    static constexpr bool PERM = true, AFTER_DRAIN = false;
    bf16 *qa, *qidx; const float* ssq0; const f32x2* rope32; const f32x2* rope16;
    __device__ __forceinline__ void operator()(AccRef acc, const Unit& u, int wr, int wc, int fr, int fq) const {
        const int pn = u.pn, row0 = u.pm * 256 + wr * 64 + fr, cl = wc * 32 + 8 * fq;
#pragma unroll
        for (int ai = 0; ai < 2; ++ai)
#pragma unroll
            for (int m = 0; m < 4; ++m) { const int row = row0 + ai * 128 + m * 16;
                const f32x4 p0 = *(const f32x4*)(ssq0 + (size_t)row * 8), p1 = *(const f32x4*)(ssq0 + (size_t)row * 8 + 4);
                const float rstd = 1.f / sqrtf((((p0[0] + p0[1]) + (p0[2] + p0[3])) + ((p1[0] + p1[1]) + (p1[2] + p1[3]))) * (1.f / 512.f) + EPS);
#pragma unroll
                for (int bj = 0; bj < 2; ++bj) { float v[8];
#pragma unroll
                    for (int e = 0; e < 8; ++e) v[e] = acc[ai][bj][m][e >> 2][e & 3] * rstd;
                    if (pn < 4) {
                        if (wc == 0) rope_head128(v, rope32 + (size_t)row * 16 + 8 * (fq & 1), fq);
#pragma unroll
                        for (int e = 0; e < 8; ++e) v[e] *= QSCALE;
                        *(v4u*)(qa + (size_t)row * 1024 + pn * 256 + bj * 128 + cl) = pack8h(v);
                    } else {
                        if ((wc & 1) == 0) rope_head64(v, rope16 + (size_t)row * 8, fq);
                        *(v4u*)(qidx + (size_t)row * 1024 + (pn - 4) * 256 + bj * 128 + cl) = pack8(v);
                    } } }
    }
};

struct EpiPlain {
    static constexpr bool PERM = true, AFTER_DRAIN = false;
    bf16* O; int ldc;
    __device__ __forceinline__ void operator()(AccRef acc, const Unit& u, int wr, int wc, int fr, int fq) const {
        const int row0 = u.pm * 256 + wr * 64 + fr, cl = u.pn * 256 + wc * 32 + 8 * fq;
#pragma unroll
        for (int ai = 0; ai < 2; ++ai)
#pragma unroll
            for (int m = 0; m < 4; ++m) { const int row = row0 + ai * 128 + m * 16;
#pragma unroll
                for (int bj = 0; bj < 2; ++bj) { float v[8];
#pragma unroll
                    for (int e = 0; e < 8; ++e) v[e] = acc[ai][bj][m][e >> 2][e & 3];
                    *(v4u*)(O + (size_t)row * ldc + bj * 128 + cl) = pack8(v); } }
    }
};

template <bool FIRST> struct EpiMerge {
    static constexpr bool PERM = true, AFTER_DRAIN = false;
    bf16* merged; const bf16* gate;
    __device__ __forceinline__ void operator()(AccRef acc, const Unit& u, int wr, int wc, int fr, int fq) const {
        const int row0 = u.pm * 256 + wr * 64 + fr, cl = u.pn * 256 + wc * 32 + 8 * fq;
#pragma unroll
        for (int ai = 0; ai < 2; ++ai)
#pragma unroll
            for (int m = 0; m < 4; ++m) { const int row = row0 + ai * 128 + m * 16;
                v4u gg[2], pp[2];
#pragma unroll
                for (int bj = 0; bj < 2; ++bj) { const size_t off = (size_t)row * 2048 + bj * 128 + cl; gg[bj] = *(const v4u*)(gate + off); if (!FIRST) pp[bj] = *(const v4u*)(merged + off); }
#pragma unroll
                for (int bj = 0; bj < 2; ++bj) { const size_t off = (size_t)row * 2048 + bj * 128 + cl; float v[8];
                    const v4u g = gg[bj];
#pragma unroll
                    for (int e = 0; e < 4; ++e) { v[2 * e] = acc[ai][bj][m][(2 * e) >> 2][(2 * e) & 3] * bflo(g[e]); v[2 * e + 1] = acc[ai][bj][m][(2 * e + 1) >> 2][(2 * e + 1) & 3] * bfhi(g[e]); }
                    if (!FIRST) { const v4u p = pp[bj];
#pragma unroll
                        for (int e = 0; e < 4; ++e) { v[2 * e] += bflo(p[e]); v[2 * e + 1] += bfhi(p[e]); } }
                    *(v4u*)(merged + off) = pack8(v); } }
    }
};

struct EpiRes {
    static constexpr bool PERM = true, AFTER_DRAIN = false;
    const float* res; float* out; bf16* xb; float* ssq;
    __device__ __forceinline__ void operator()(AccRef acc, const Unit& u, int wr, int wc, int fr, int fq) const {
        const int row0 = u.pm * 256 + wr * 64 + fr, cl = u.pn * 256 + wc * 32 + 8 * fq;
#pragma unroll
        for (int ai = 0; ai < 2; ++ai)
#pragma unroll
            for (int m = 0; m < 4; ++m) { const int row = row0 + ai * 128 + m * 16; float ss = 0.f;
                f32x4 rr[2][2];
#pragma unroll
                for (int bj = 0; bj < 2; ++bj) { const size_t off = (size_t)row * 2048 + bj * 128 + cl; rr[bj][0] = *(const f32x4*)(res + off); rr[bj][1] = *(const f32x4*)(res + off + 4); }
#pragma unroll
                for (int bj = 0; bj < 2; ++bj) { const size_t off = (size_t)row * 2048 + bj * 128 + cl;
                    const f32x4 a0 = acc[ai][bj][m][0] + rr[bj][0], a1 = acc[ai][bj][m][1] + rr[bj][1];
                    *(f32x4*)(out + off) = a0; *(f32x4*)(out + off + 4) = a1;
                    float v[8] = {a0[0], a0[1], a0[2], a0[3], a1[0], a1[1], a1[2], a1[3]};
#pragma unroll
                    for (int e = 0; e < 8; ++e) ss += v[e] * v[e];
                    if (xb) *(v4u*)(xb + off) = pack8(v); }
                ss += __shfl_xor(ss, 16); ss += __shfl_xor(ss, 32);
                if (ssq && fq == 0) unsafeAtomicAdd(ssq + row, ss); }
    }
};

template <int ACT  > struct EpiNormed {
    static constexpr bool PERM = true, AFTER_DRAIN = false;
    bf16* O; int ldc; const float* ssq; float sc;
    __device__ __forceinline__ void operator()(AccRef acc, const Unit& u, int wr, int wc, int fr, int fq) const {
        const int row0 = u.pm * 256 + wr * 64 + fr, cl = u.pn * 256 + wc * 32 + 8 * fq;
        float sq[2][4];
#pragma unroll
        for (int ai = 0; ai < 2; ++ai)
#pragma unroll
            for (int m = 0; m < 4; ++m) sq[ai][m] = ssq[row0 + ai * 128 + m * 16];
#pragma unroll
        for (int ai = 0; ai < 2; ++ai)
#pragma unroll
            for (int m = 0; m < 4; ++m) { const int row = row0 + ai * 128 + m * 16;
                const float rs = sc / sqrtf(sq[ai][m] * (1.f / 2048.f) + EPS);
#pragma unroll
                for (int bj = 0; bj < 2; ++bj) { float v[8];
#pragma unroll
                    for (int e = 0; e < 8; ++e) { float x = acc[ai][bj][m][e >> 2][e & 3] * rs; if (ACT == 1) { x = fmaxf(x, 0.f); x = x * x; } v[e] = x; }
                    *(v4u*)(O + (size_t)row * ldc + bj * 128 + cl) = pack8(v); } }
    }
};

__device__ __forceinline__ int mapcol_in(int s) { return s < 2560 ? s : (s < 2624 ? 9728 + (s - 2560) : (s < 2640 ? 9792 + (s - 2624) : s - 80)); }
__device__ __forceinline__ void tr_item(const float* __restrict__ W, int K, int N, bf16* WT, int roff, const float* gk, int mode, LAS float* scr, int item, int lane) {
    const int nblk = (N + 31) >> 5, kb = item / nblk, nb = item - kb * nblk, k0 = 64 * kb, n0 = 32 * nb;
    const int nn = n0 + (lane & 31);
    const int nnc = nn < N ? nn : N - 1; const float* wp = W + (size_t)(k0 + (lane >> 5)) * N + nnc;
    const float gkv = gk ? gk[k0 + lane] : 1.f;
#pragma unroll
    for (int h16 = 0; h16 < 2; ++h16) {
        float wv[16];
#pragma unroll
        for (int i = 0; i < 16; ++i) wv[i] = wp[(size_t)(2 * (16 * h16 + i)) * N];
        __builtin_amdgcn_sched_barrier(0);
#pragma unroll
        for (int i = 0; i < 16; ++i) { const int kk = 2 * (16 * h16 + i) + (lane >> 5); float v = nn < N ? wv[i] : 0.f; v *= __shfl(gkv, kk); scr[kk * 33 + (lane & 31)] = v; }
    }
    LDS_WAIT();
    const int c = lane & 7;
#pragma unroll
    for (int j = 0; j < 4; ++j) { const int nl = (lane >> 3) + 8 * j, n = n0 + nl;
        if (n < N) { const LAS float* s = scr + (8 * c) * 33 + nl;
            v4u o; o.x = cvt_pk_bf16(s[0 * 33], s[1 * 33]); o.y = cvt_pk_bf16(s[2 * 33], s[3 * 33]); o.z = cvt_pk_bf16(s[4 * 33], s[5 * 33]); o.w = cvt_pk_bf16(s[6 * 33], s[7 * 33]);
            const int dr = mode ? mapcol_in(n) : n + roff;
            *(v4u*)(WT + (size_t)dr * K + k0 + 8 * c) = o; } }
    LDS_WAIT();
}
__device__ __forceinline__ void rms_row_to_bf16(const float* xrow, const float* g, bf16* orow, int lane) {
    const f32x4* xr = (const f32x4*)xrow + lane; const f32x4* gr = (const f32x4*)g + lane;
    f32x4 v[8]; float s = 0.f;
#pragma unroll
    for (int j = 0; j < 8; ++j) { v[j] = xr[64 * j]; s += (v[j].x * v[j].x + v[j].y * v[j].y) + (v[j].z * v[j].z + v[j].w * v[j].w); }
    const float rstd = 1.f / sqrtf(wave_sum(s) * (1.f / 2048.f) + EPS);
    v2u* o8 = (v2u*)orow + lane;
#pragma unroll
    for (int j = 0; j < 8; ++j) { const f32x4 gv = gr[64 * j]; v2u o; o.x = cvt_pk_bf16(v[j].x * rstd * gv.x, v[j].y * rstd * gv.y); o.y = cvt_pk_bf16(v[j].z * rstd * gv.z, v[j].w * rstd * gv.w); o8[64 * j] = o; }
}
__device__ const float ROPE_INV[16] = {1.0f, 0.44036659598350525f, 0.1939227432012558f, 0.08539710193872452f, 0.03760603070259094f, 0.01656043902039528f, 0.007292664609849453f, 0.0032114458736032248f,
    0.0014142135623842478f, 0.000622772378847003f, 0.00027424818836152554f, 0.00012076973507646471f, 5.318296098266728e-05f, 2.34199997066753e-05f, 1.0313386155758053e-05f, 4.541670477919979e-06f};
__device__ __forceinline__ f32x2 rope_cs(int pos, float inv) {
    const float ang = __fmul_rn((float)pos, inv);
    const double a = (double)ang, k = __builtin_rint(a * 0.15915494309189535), r = __builtin_fma(-k, 6.283185307179586, a);
    const float rf = (float)r; f32x2 o; o.x = __cosf(rf); o.y = __sinf(rf); return o;
}

constexpr int AK_STRIDE = 272  , AV_STRIDE = 288  , AK_OFF = 0, AV_OFF = 64 * AK_STRIDE, ABUF = AV_OFF + 64 * AV_STRIDE  , AU_OFF = 2 * ABUF;
typedef short v4i16_t __attribute__((ext_vector_type(4)));
__device__ __forceinline__ v4i16_t tr_read(LAS unsigned char* p) { return __builtin_amdgcn_ds_read_tr16_b64_v4i16((LAS v4i16_t*)p); }
template <bool MOBA>
__device__ __forceinline__ void attn_unit(LAS unsigned char* lds, const bf16* Qp, int ldq, const bf16* Kp, int ldk, const bf16* Vp, int ldv, bf16* Op, int ldo,
                                          int cur  , int s0  , const bf16* kmp  ) {
    const int tid = threadIdx.x, lane = tid & 63, wave = __builtin_amdgcn_readfirstlane(tid >> 6), fr = lane & 15, quad = lane >> 4;
    const int qrow0 = wave * 32 + fr;
    bf16x8 bq[2][4];
#pragma unroll
    for (int g = 0; g < 2; ++g)
#pragma unroll
        for (int kk = 0; kk < 4; ++kk) bq[g][kk] = *(const bf16x8*)(Qp + (size_t)(qrow0 + 16 * g) * ldq + kk * 32 + quad * 8);
    unsigned selmask[2] = {0u, 0u}, umask = 0xffffffffu;
    if (MOBA) {
        unsigned um = 0u;
#pragma unroll
        for (int g = 0; g < 2; ++g) {
            f32x4 gt[2];
#pragma unroll
            for (int mt = 0; mt < 2; ++mt) { gt[mt] = (f32x4){0.f, 0.f, 0.f, 0.f};
#pragma unroll
                for (int kk = 0; kk < 4; ++kk) { const bf16x8 a = *(const bf16x8*)(kmp + (size_t)(mt * 16 + fr) * 1024 + kk * 32 + quad * 8);
                    gt[mt] = __builtin_amdgcn_mfma_f32_16x16x32_bf16(a, bq[g][kk], gt[mt], 0, 0, 0); } }
            unsigned sm = 0u;
#pragma unroll
            for (int it = 0; it < 3; ++it) { float bv = -INFINITY; int bi = 64;
#pragma unroll
                for (int mt = 0; mt < 2; ++mt)
#pragma unroll
                    for (int r = 0; r < 4; ++r) { const int id = mt * 16 + quad * 4 + r; const float val = gt[mt][r];
                        if (id < cur && !((sm >> id) & 1u) && (val > bv || (val == bv && id < bi))) { bv = val; bi = id; } }
#pragma unroll
                for (int off = 16; off <= 32; off <<= 1) { const float ov = __shfl_xor(bv, off); const int oi = __shfl_xor(bi, off);
                    if (ov > bv || (ov == bv && oi < bi)) { bv = ov; bi = oi; } }
                if (bi < 64) sm |= 1u << bi; }
            selmask[g] = sm; um |= sm; }
#pragma unroll
        for (int off = 1; off < 16; off <<= 1) um |= (unsigned)__shfl_xor((int)um, off);
        LAS unsigned* uw = (LAS unsigned*)(lds + AU_OFF);
        __syncthreads();
        if (tid == 0) *uw = 0u;
        __syncthreads();
        if (lane == 0) atomicOr((unsigned*)uw, um);
        __syncthreads();
        umask = *uw;
    }
    f32x4 o[2][8];
#pragma unroll
    for (int g = 0; g < 2; ++g)
#pragma unroll
        for (int mt = 0; mt < 8; ++mt) o[g][mt] = (f32x4){0.f, 0.f, 0.f, 0.f};
    float m_run[2] = {-INFINITY, -INFINITY}, l_run[2] = {0.f, 0.f};
    const int ntiles = MOBA ? (cur + 1) * 4 : cur;
#define ATT_TILE_OK(t) (!MOBA || ((t) >> 2) >= cur || ((umask >> ((t) >> 2)) & 1u) != 0u)
    const int sk0 = tid >> 4, sp = tid & 15;
    const bf16* kg = Kp + (size_t)sk0 * ldk + sp * 8; const bf16* vg = Vp + (size_t)sk0 * ldv + sp * 8;
    LAS unsigned char* kl = lds + AK_OFF + sk0 * AK_STRIDE + sp * 16; LAS unsigned char* vl = lds + AV_OFF + sk0 * AV_STRIDE + sp * 16;
    int kt = 0; while (kt < ntiles && !ATT_TILE_OK(kt)) ++kt;
    v4u kr0, kr1, vr0, vr1;
    { const size_t ko = (size_t)kt * 64 * ldk, vo = (size_t)kt * 64 * ldv;
      kr0 = *(const v4u*)(kg + ko); kr1 = *(const v4u*)(kg + ko + (size_t)32 * ldk); vr0 = *(const v4u*)(vg + vo); vr1 = *(const v4u*)(vg + vo + (size_t)32 * ldv); }
    LAS unsigned char* vt = lds + AV_OFF + (4 * quad + ((lane & 15) >> 2)) * AV_STRIDE + 8 * (lane & 3);
    int par = 0;
    __syncthreads();
    *(LAS v4u*)kl = kr0; *(LAS v4u*)(kl + 32 * AK_STRIDE) = kr1; *(LAS v4u*)vl = vr0; *(LAS v4u*)(vl + 32 * AV_STRIDE) = vr1;
    int nkt = kt + 1; while (nkt < ntiles && !ATT_TILE_OK(nkt)) ++nkt;
    if (nkt < ntiles) { const size_t ko = (size_t)nkt * 64 * ldk, vo = (size_t)nkt * 64 * ldv;
        kr0 = *(const v4u*)(kg + ko); kr1 = *(const v4u*)(kg + ko + (size_t)32 * ldk); vr0 = *(const v4u*)(vg + vo); vr1 = *(const v4u*)(vg + vo + (size_t)32 * ldv); }
    __syncthreads();
    while (kt < ntiles) {
        const int blk = kt >> 2, key0 = kt * 64;
        int nnkt = ntiles;
        if (nkt < ntiles) { const int ob = (par ^ 1) * ABUF;
            *(LAS v4u*)(kl + ob) = kr0; *(LAS v4u*)(kl + ob + 32 * AK_STRIDE) = kr1; *(LAS v4u*)(vl + ob) = vr0; *(LAS v4u*)(vl + ob + 32 * AV_STRIDE) = vr1;
            nnkt = nkt + 1; while (nnkt < ntiles && !ATT_TILE_OK(nnkt)) ++nnkt;
            if (nnkt < ntiles) { const size_t ko = (size_t)nnkt * 64 * ldk, vo = (size_t)nnkt * 64 * ldv;
                kr0 = *(const v4u*)(kg + ko); kr1 = *(const v4u*)(kg + ko + (size_t)32 * ldk); vr0 = *(const v4u*)(vg + vo); vr1 = *(const v4u*)(vg + vo + (size_t)32 * ldv); } }
        LAS unsigned char* const tb = lds + par * ABUF;
        f32x4 st[2][4];
#pragma unroll
        for (int g = 0; g < 2; ++g)
#pragma unroll
            for (int mt = 0; mt < 4; ++mt) st[g][mt] = (f32x4){0.f, 0.f, 0.f, 0.f};
#pragma unroll
        for (int mt = 0; mt < 4; ++mt)
#pragma unroll
            for (int kk = 0; kk < 4; ++kk) { const bf16x8 a = *(const LAS bf16x8*)(tb + AK_OFF + (mt * 16 + fr) * AK_STRIDE + (kk * 32 + quad * 8) * 2);
                st[0][mt] = __builtin_amdgcn_mfma_f32_16x16x32_bf16(a, bq[0][kk], st[0][mt], 0, 0, 0);
                st[1][mt] = __builtin_amdgcn_mfma_f32_16x16x32_bf16(a, bq[1][kk], st[1][mt], 0, 0, 0); }
        bf16x8 pb[2][2];
#pragma unroll
        for (int g = 0; g < 2; ++g) {
            if (MOBA) {
                if (blk < cur) { if (!((selmask[g] >> blk) & 1u)) {
#pragma unroll
                        for (int mt = 0; mt < 4; ++mt) st[g][mt] = (f32x4){-INFINITY, -INFINITY, -INFINITY, -INFINITY}; } }
                else { const int qpos = s0 + qrow0 + 16 * g;
#pragma unroll
                    for (int mt = 0; mt < 4; ++mt)
#pragma unroll
                        for (int r = 0; r < 4; ++r) if (key0 + mt * 16 + quad * 4 + r > qpos) st[g][mt][r] = -INFINITY; }
            }
            float mx = -INFINITY;
#pragma unroll
            for (int mt = 0; mt < 4; ++mt)
#pragma unroll
                for (int r = 0; r < 4; ++r) mx = fmaxf(mx, st[g][mt][r]);
            mx = fmaxf(mx, __shfl_xor(mx, 16)); mx = fmaxf(mx, __shfl_xor(mx, 32));
            const float m_new = fmaxf(m_run[g], mx), m_use = (m_new == -INFINITY) ? 0.f : m_new;
            const float alpha = fexp2(m_run[g] - m_use);
            m_run[g] = m_new;
            float ps = 0.f;
#pragma unroll
            for (int mt = 0; mt < 4; ++mt)
#pragma unroll
                for (int r = 0; r < 4; ++r) { const float p = fexp2(st[g][mt][r] - m_use); st[g][mt][r] = p; ps += p; }
            l_run[g] = l_run[g] * alpha + ps;
            if (__ballot(alpha != 1.f) != 0ull) {
#pragma unroll
                for (int mt = 0; mt < 8; ++mt) o[g][mt] = o[g][mt] * alpha; }
#pragma unroll
            for (int ks = 0; ks < 2; ++ks) { v4u w; w.x = cvt_pk_bf16(st[g][2 * ks][0], st[g][2 * ks][1]); w.y = cvt_pk_bf16(st[g][2 * ks][2], st[g][2 * ks][3]);
                w.z = cvt_pk_bf16(st[g][2 * ks + 1][0], st[g][2 * ks + 1][1]); w.w = cvt_pk_bf16(st[g][2 * ks + 1][2], st[g][2 * ks + 1][3]); pb[g][ks] = __builtin_bit_cast(bf16x8, w); }
        }
#pragma unroll
        for (int c8 = 0; c8 < 8; ++c8)
#pragma unroll
            for (int ks = 0; ks < 2; ++ks) { const v4i16_t t0 = tr_read(vt + par * ABUF + (32 * ks) * AV_STRIDE + 32 * c8), t1 = tr_read(vt + par * ABUF + (32 * ks + 16) * AV_STRIDE + 32 * c8);
                const bf16x8 a = (bf16x8){t0[0], t0[1], t0[2], t0[3], t1[0], t1[1], t1[2], t1[3]};
                o[0][c8] = __builtin_amdgcn_mfma_f32_16x16x32_bf16(a, pb[0][ks], o[0][c8], 0, 0, 0);
                o[1][c8] = __builtin_amdgcn_mfma_f32_16x16x32_bf16(a, pb[1][ks], o[1][c8], 0, 0, 0); }
        __syncthreads();
        kt = nkt; nkt = nnkt; par ^= 1;
    }
#undef ATT_TILE_OK
#pragma unroll
    for (int g = 0; g < 2; ++g) {
        float l = l_run[g]; l += __shfl_xor(l, 16); l += __shfl_xor(l, 32);
        const float inv = 1.f / l;
#pragma unroll
        for (int mt = 0; mt < 8; ++mt) { v2u w; w.x = cvt_pk_bf16(o[g][mt][0] * inv, o[g][mt][1] * inv); w.y = cvt_pk_bf16(o[g][mt][2] * inv, o[g][mt][3] * inv);
            *(v2u*)(Op + (size_t)(qrow0 + 16 * g) * ldo + mt * 16 + quad * 4) = w; } }
    __syncthreads();
}

constexpr int DS_S_OFF = 40960, DS_SEL_OFF = DS_S_OFF + 8 * 8192, DS_P_OFF = DS_SEL_OFF + 8 * 1024;
__device__ __forceinline__ unsigned ord_key(float f) { if (f == 0.f) f = 0.f; const unsigned b = __builtin_bit_cast(unsigned, f); return b ^ ((b >> 31) ? 0xffffffffu : 0x80000000u); }

#define SEL_COUNT(cnt, OP, x) do { _Pragma("unroll") for (int c16 = 0; c16 < 8; ++c16) { if (c16 * 16 < ngq) { _Pragma("unroll") for (int i = 0; i < 16; ++i) cnt += (v[c16 * 16 + i] OP (x)) ? 1 : 0; } } } while (0)
__device__ __forceinline__ void dsa_group(LAS unsigned char* lds, int b, int t0, float* scr  , const bf16* qidx, const bf16* kidx, const float* widx,
                                          unsigned short* selg) {
    const int tid = threadIdx.x, lane = tid & 63, wave = __builtin_amdgcn_readfirstlane(tid >> 6), fr = lane & 15, quad = lane >> 4;
#ifndef DSA_NO_I
    {
        bf16x8 aq[8][2]; float wq[8][4];
#pragma unroll
        for (int q = 0; q < 8; ++q) { const size_t tok = (size_t)b * SEQ + t0 + q;
#pragma unroll
            for (int kk = 0; kk < 2; ++kk) aq[q][kk] = *(const bf16x8*)(qidx + tok * 1024 + fr * 64 + kk * 32 + quad * 8);
            const f32x4 w4 = *(const f32x4*)(widx + tok * 16 + quad * 4);
            wq[q][0] = w4[0]; wq[q][1] = w4[1]; wq[q][2] = w4[2]; wq[q][3] = w4[3]; }
        const int ng = ((t0 + 7) >> 6) + 1;
        bf16x8 bk[4][2];
        { const int g = wave < ng ? wave : 0;
#pragma unroll
          for (int cc = 0; cc < 4; ++cc) { const size_t krow = (size_t)b * SEQ + g * 64 + cc * 16 + fr;
              bk[cc][0] = *(const bf16x8*)(kidx + krow * 64 + quad * 8); bk[cc][1] = *(const bf16x8*)(kidx + krow * 64 + 32 + quad * 8); } }
        for (int g = wave; g < ng; g += 8) {
            float r[8];
#pragma unroll
            for (int q = 0; q < 8; ++q) r[q] = 0.f;
            bf16x8 cur[4][2];
#pragma unroll
            for (int cc = 0; cc < 4; ++cc) { cur[cc][0] = bk[cc][0]; cur[cc][1] = bk[cc][1]; }
            { const int gn = g + 8 < ng ? g + 8 : g;
#pragma unroll
              for (int cc = 0; cc < 4; ++cc) { const size_t krow = (size_t)b * SEQ + gn * 64 + cc * 16 + fr;
                  bk[cc][0] = *(const bf16x8*)(kidx + krow * 64 + quad * 8); bk[cc][1] = *(const bf16x8*)(kidx + krow * 64 + 32 + quad * 8); } }
#pragma unroll
            for (int q = 0; q < 8; ++q) { float sp[4];
#pragma unroll
                for (int cc = 0; cc < 4; ++cc) { f32x4 a = (f32x4){0.f, 0.f, 0.f, 0.f};
                    a = __builtin_amdgcn_mfma_f32_16x16x32_bf16(aq[q][0], cur[cc][0], a, 0, 0, 0);
                    a = __builtin_amdgcn_mfma_f32_16x16x32_bf16(aq[q][1], cur[cc][1], a, 0, 0, 0);
                    sp[cc] = wq[q][0] * fmaxf(a[0], 0.f) + wq[q][1] * fmaxf(a[1], 0.f) + wq[q][2] * fmaxf(a[2], 0.f) + wq[q][3] * fmaxf(a[3], 0.f); }
                const float m0 = (quad & 2) ? sp[2] : sp[0], m1 = (quad & 2) ? sp[3] : sp[1], s0 = (quad & 2) ? sp[0] : sp[2], s1 = (quad & 2) ? sp[1] : sp[3];
                const float t0 = m0 + __shfl_xor(s0, 32), t1 = m1 + __shfl_xor(s1, 32);
                r[q] = ((quad & 1) ? t1 : t0) + __shfl_xor((quad & 1) ? t0 : t1, 16); }
#pragma unroll
            for (int q = 0; q < 8; ++q) scr[q * 8192 + g * 64 + lane] = r[q];
        }
    }
#endif
    __syncthreads();
    const int t = t0 + wave, n = t + 1;
    LAS int* sel = (LAS int*)(lds + DS_SEL_OFF + wave * 1024);
    LAS float* Sl = (LAS float*)(lds + DS_S_OFF + wave * 8192);
    int nsel;
#ifdef DSA_NO_II
    nsel = n < 256 ? n : 256; for (int k = 0; k < 4; ++k) sel[k * 64 + lane] = k * 64 + lane;
#else
    {
        unsigned v[128];
        const int ngq = (t >> 6) + 1; const float* row = scr + wave * 8192;
#define SEL_LD(i) asm volatile("global_load_dword %0, %1, %2 offset:%3 sc0" : "=v"(v[c16 * 16 + (i)]) : "v"(voff), "s"(rp), "n"((i) * 256))
#define SEL_TIE(k) asm volatile("" : "+v"(v[(k) * 16 + 0]), "+v"(v[(k) * 16 + 1]), "+v"(v[(k) * 16 + 2]), "+v"(v[(k) * 16 + 3]), "+v"(v[(k) * 16 + 4]), "+v"(v[(k) * 16 + 5]), "+v"(v[(k) * 16 + 6]), "+v"(v[(k) * 16 + 7]), \
        "+v"(v[(k) * 16 + 8]), "+v"(v[(k) * 16 + 9]), "+v"(v[(k) * 16 + 10]), "+v"(v[(k) * 16 + 11]), "+v"(v[(k) * 16 + 12]), "+v"(v[(k) * 16 + 13]), "+v"(v[(k) * 16 + 14]), "+v"(v[(k) * 16 + 15]))
        const unsigned voff = (unsigned)lane * 4u;
#pragma unroll
        for (int c16 = 0; c16 < 8; ++c16) {
            if (c16 * 16 < ngq) { const float* rp = row + c16 * 1024;
                SEL_LD(0); SEL_LD(1); SEL_LD(2); SEL_LD(3); SEL_LD(4); SEL_LD(5); SEL_LD(6); SEL_LD(7); SEL_LD(8); SEL_LD(9); SEL_LD(10); SEL_LD(11); SEL_LD(12); SEL_LD(13); SEL_LD(14); SEL_LD(15);
            } else {
#pragma unroll
                for (int i = 0; i < 16; ++i) v[c16 * 16 + i] = 0u;
            } }
        asm volatile("s_waitcnt vmcnt(0)" ::: "memory");
        SEL_TIE(0); SEL_TIE(1); SEL_TIE(2); SEL_TIE(3); SEL_TIE(4); SEL_TIE(5); SEL_TIE(6); SEL_TIE(7);
#undef SEL_LD
#undef SEL_TIE
#pragma unroll
        for (int c16 = 0; c16 < 8; ++c16) { if (c16 * 16 < ngq) {
#pragma unroll
            for (int i = 0; i < 16; ++i) { const int ii = c16 * 16 + i; v[ii] = (ii * 64 + lane <= t) ? ord_key(__builtin_bit_cast(float, v[ii])) : 0u; } } }
        __syncthreads();
        if (n <= 256) { nsel = n;
#pragma unroll
            for (int k = 0; k < 4; ++k) sel[k * 64 + lane] = k * 64 + lane;
        } else {
            nsel = 256;
            unsigned theta = 0u; bool exact = false; int bit0 = 31;
            { unsigned vm = 0u;
#pragma unroll
              for (int c16 = 0; c16 < 8; ++c16) { if (c16 * 16 < ngq) {
#pragma unroll
                  for (int i = 0; i < 16; ++i) vm = v[c16 * 16 + i] > vm ? v[c16 * 16 + i] : vm; } }
#pragma unroll
              for (int o = 1; o < 64; o <<= 1) { const unsigned ov = (unsigned)__shfl_xor((int)vm, o); vm = ov > vm ? ov : vm; }
              const unsigned p0 = vm >> 23;
              for (unsigned k = 0; k < 4 && k <= p0; ++k) { const unsigned cand = (p0 - k) << 23; int cnt = 0;
                  SEL_COUNT(cnt, >=, cand);
                  cnt = wave_sum_i(cnt);
                  if (cnt >= 256) { theta = cand; exact = (cnt == 256); bit0 = 22; break; } } }
            if (!exact)
            for (int bit = bit0; bit >= 0; --bit) { const unsigned cand = theta | (1u << bit); int cnt = 0;
                SEL_COUNT(cnt, >=, cand);
                cnt = wave_sum_i(cnt);
                if (cnt >= 256) { theta = cand; if (cnt == 256) { exact = true; break; } } }
            const unsigned lo = exact ? theta - 1u : theta;
            int cgt = 256;
            if (!exact) { int cnt = 0;
                SEL_COUNT(cnt, >, lo);
                cgt = wave_sum_i(cnt); }
            const int need_eq = 256 - cgt;
            int base_gt = 0, base_eq = 0;
#pragma unroll
            for (int i = 0; i < 128; ++i) { if ((i & ~15) < ngq) {
                const bool gt = v[i] > lo;
                const unsigned long long mg = __ballot(gt);
                const int pg = __builtin_amdgcn_mbcnt_hi((unsigned)(mg >> 32), __builtin_amdgcn_mbcnt_lo((unsigned)mg, 0));
                if (gt) sel[base_gt + pg] = i * 64 + lane;
                base_gt += __builtin_popcountll(mg); } }
            if (need_eq > 0) {
#pragma unroll
                for (int i = 0; i < 128; ++i) { if ((i & ~15) < ngq) {
                    const bool eq = v[i] == lo;
                    const unsigned long long me = __ballot(eq);
                    const int pe = __builtin_amdgcn_mbcnt_hi((unsigned)(me >> 32), __builtin_amdgcn_mbcnt_lo((unsigned)me, 0));
                    if (eq && (base_eq + pe) < need_eq) sel[cgt + base_eq + pe] = i * 64 + lane;
                    base_eq += __builtin_popcountll(me); } } }
        }
    }
#endif
    LDS_WAIT();
    { const size_t tok = (size_t)b * SEQ + t; v2u w; w.x = (unsigned)sel[4 * lane] | ((unsigned)sel[4 * lane + 1] << 16); w.y = (unsigned)sel[4 * lane + 2] | ((unsigned)sel[4 * lane + 3] << 16);
      *(v2u*)(selg + tok * 256 + 4 * lane) = w; }
    LDS_WAIT();
}

constexpr int DA_SEL_OFF = 0, DA_S_OFF = 8 * 512;
__device__ __forceinline__ void dsa_qk_item(LAS unsigned char* lds, int wave, int lane, int b, int t, int hx, const unsigned short* selg, const bf16* qa, const bf16* ka, bf16* pg) {
    const int fr = lane & 15, quad = lane >> 4;
    LAS unsigned short* Ls = (LAS unsigned short*)(lds + DA_SEL_OFF + wave * 512);
    LAS float* Sp = (LAS float*)(lds + DA_S_OFF + wave * 1024);
    const size_t tok = (size_t)b * SEQ + t; const int nsel = t + 1 < 256 ? t + 1 : 256;
    *(LAS v2u*)(Ls + 4 * lane) = *(const v2u*)(selg + tok * 256 + 4 * lane);
    const v4u qh = *(const v4u*)(qa + tok * 1024 + hx * 128 + fr * 8);
    LDS_WAIT();
    const bf16* kbase = ka + (size_t)b * SEQ * 1024 + hx * 128 + fr * 8;
    for (int n0 = 0; n0 < 256; n0 += 64) {
        int keys[16];
#pragma unroll
        for (int u = 0; u < 16; ++u) { const int n = n0 + 4 * u + quad; keys[u] = Ls[n]; if (n >= nsel) keys[u] = 0; }
        v4u kv[16];
#pragma unroll
        for (int u = 0; u < 16; ++u) kv[u] = *(const v4u*)(kbase + (size_t)keys[u] * 1024);
        __builtin_amdgcn_sched_barrier(0);
        float d[16];
#pragma unroll
        for (int u = 0; u < 16; ++u) { float a = 0.f;
#pragma unroll
            for (int e = 0; e < 4; ++e) a = hdot2(kv[u][e], qh[e], a);
            d[u] = a; }
        float r8[8], r4[4], r2[2];
#pragma unroll
        for (int u = 0; u < 8; ++u) { const float mine = (fr & 8) ? d[u + 8] : d[u], send = (fr & 8) ? d[u] : d[u + 8]; r8[u] = mine + __shfl_xor(send, 8); }
#pragma unroll
        for (int u = 0; u < 4; ++u) { const float mine = (fr & 4) ? r8[u + 4] : r8[u], send = (fr & 4) ? r8[u] : r8[u + 4]; r4[u] = mine + __shfl_xor(send, 4); }
#pragma unroll
        for (int u = 0; u < 2; ++u) { const float mine = (fr & 2) ? r4[u + 2] : r4[u], send = (fr & 2) ? r4[u] : r4[u + 2]; r2[u] = mine + __shfl_xor(send, 2); }
        { const float mine = (fr & 1) ? r2[1] : r2[0], send = (fr & 1) ? r2[0] : r2[1]; Sp[n0 + 4 * fr + quad] = mine + __shfl_xor(send, 1); }
        __builtin_amdgcn_sched_barrier(0);
    }
    LDS_WAIT();
    f32x4 sc = *(const LAS f32x4*)(Sp + 4 * lane);
    float mx = -INFINITY;
#pragma unroll
    for (int r = 0; r < 4; ++r) { if (4 * lane + r >= nsel) sc[r] = -INFINITY; mx = fmaxf(mx, sc[r]); }
#pragma unroll
    for (int o = 1; o < 64; o <<= 1) mx = fmaxf(mx, __shfl_xor(mx, o));
    float l = 0.f;
#pragma unroll
    for (int r = 0; r < 4; ++r) { sc[r] = fexp2(sc[r] - mx); l += sc[r]; }
    l = wave_sum(l);
    const float inv = 1.f / l;
    v2u w; w.x = cvt_pk_f16(sc[0] * inv, sc[1] * inv); w.y = cvt_pk_f16(sc[2] * inv, sc[3] * inv);
    *(v2u*)(pg + (tok * 8 + hx) * 256 + 4 * lane) = w;
    LDS_WAIT();
}
__device__ __forceinline__ void dsa_pv_item(LAS unsigned char* lds, int wave, int lane, int b, int t, int hx, const unsigned short* selg, const bf16* pg, const bf16* va, bf16* odsa) {
    const int fr = lane & 15, quad = lane >> 4;
    LAS unsigned short* Ls = (LAS unsigned short*)(lds + DA_SEL_OFF + wave * 512);
    LAS unsigned short* Lp = (LAS unsigned short*)(lds + DA_S_OFF + wave * 1024);
    const size_t tok = (size_t)b * SEQ + t; const int nsel = t + 1 < 256 ? t + 1 : 256;
    *(LAS v2u*)(Ls + 4 * lane) = *(const v2u*)(selg + tok * 256 + 4 * lane);
    *(LAS v2u*)(Lp + 4 * lane) = *(const v2u*)(pg + (tok * 8 + hx) * 256 + 4 * lane);
    LDS_WAIT();
    float acc[8];
#pragma unroll
    for (int e = 0; e < 8; ++e) acc[e] = 0.f;
    const bf16* vbase = va + (size_t)b * SEQ * 1024 + hx * 128 + fr * 8;
    for (int n0 = 0; n0 < 256; n0 += 64) {
        int keys[16]; unsigned pp[8];
#pragma unroll
        for (int u = 0; u < 16; ++u) { const int n = n0 + 4 * u + quad; keys[u] = Ls[n]; if (n >= nsel) keys[u] = 0; }
#pragma unroll
        for (int u = 0; u < 8; ++u) pp[u] = (unsigned)Lp[n0 + 8 * u + quad] | ((unsigned)Lp[n0 + 8 * u + 4 + quad] << 16);
        v4u vv[16];
#pragma unroll
        for (int u = 0; u < 16; ++u) vv[u] = *(const v4u*)(vbase + (size_t)keys[u] * 1024);
        __builtin_amdgcn_sched_barrier(0);
#pragma unroll
        for (int u = 0; u < 8; ++u)
#pragma unroll
            for (int e = 0; e < 4; ++e) {
                acc[2 * e] = hdot2(__builtin_amdgcn_perm(vv[2 * u + 1][e], vv[2 * u][e], 0x05040100u), pp[u], acc[2 * e]);
                acc[2 * e + 1] = hdot2(__builtin_amdgcn_perm(vv[2 * u + 1][e], vv[2 * u][e], 0x07060302u), pp[u], acc[2 * e + 1]); }
        __builtin_amdgcn_sched_barrier(0);
    }
#pragma unroll
    for (int e = 0; e < 8; ++e) { acc[e] += __shfl_xor(acc[e], 16); acc[e] += __shfl_xor(acc[e], 32); }
    if (quad == 0) *(v4u*)(odsa + tok * 1024 + hx * 128 + fr * 8) = pack8(acc);
    LDS_WAIT();
}

#define XB_TMO      128
#define XB_XCNT(j)  (256  + 64 * (j))
#define XB_XSUB(j)  (1280 + 64 * (j))
#define XB_XGEN(j)  (2304 + 64 * (j))
#define XB_TOP      3328
#define XB_TOPGEN   3392
#define XCD_BAR_WORDS 3456
#define XB_SPIN_CAP (1u << 18)

__device__ __forceinline__ unsigned xb_ld(unsigned* p)              { return __hip_atomic_load(p, __ATOMIC_RELAXED, __HIP_MEMORY_SCOPE_AGENT); }
__device__ __forceinline__ unsigned xb_add(unsigned* p, unsigned v) { return __hip_atomic_fetch_add(p, v, __ATOMIC_RELAXED, __HIP_MEMORY_SCOPE_AGENT); }
__device__ __forceinline__ unsigned xb_xcc_id() { return (unsigned)__builtin_amdgcn_s_getreg((3 << 11) | 20) & 0xFu; }
#define XB_SPIN(cond, bar) do { unsigned _sp = 0; while (cond) { __builtin_amdgcn_s_sleep(1); \
    if ((++_sp & 255u) == 0u) { if (xb_ld(&(bar)[XB_TMO])) break; if (_sp > XB_SPIN_CAP) { atomicAdd(&(bar)[XB_TMO], 1u); break; } } } } while (0)

struct XcdBarrier {
    unsigned* bar; unsigned x;
    volatile LAS unsigned* st;
};

__device__ __forceinline__ XcdBarrier xcd_barrier_post(unsigned* bar, volatile LAS unsigned* st) {
    XcdBarrier b; b.bar = bar; b.x = xb_xcc_id(); b.st = st;
    if (threadIdx.x == 0) (void)xb_add(&bar[XB_XCNT(b.x)], 1u);
    return b;
}
__device__ __forceinline__ void xcd_barrier_complete(unsigned* bar, unsigned x, unsigned& nloc, unsigned& nx) {
    const unsigned G = gridDim.x * gridDim.y * gridDim.z;
    unsigned sum, cnt, mine, sp = 0u;
    for (;;) {
        sum = 0u; cnt = 0u; mine = 0u;
#pragma unroll
        for (unsigned j = 0; j < 16; ++j) { const unsigned c = xb_ld(&bar[XB_XCNT(j)]); sum += c; cnt += (c > 0u) ? 1u : 0u; mine = (j == x) ? c : mine; }
        if (sum == G) break;
        __builtin_amdgcn_s_sleep(1);
        if ((++sp & 255u) == 0u) { if (xb_ld(&bar[XB_TMO])) break; if (sp > XB_SPIN_CAP) { atomicAdd(&bar[XB_TMO], 1u); break; } }
    }
    nloc = mine > 0u ? mine : 1u; nx = cnt > 0u ? cnt : 1u;
}

__device__ __forceinline__ void xcd_barrier(const XcdBarrier& b) {
    asm volatile("s_waitcnt vmcnt(0)" ::: "memory");
    __syncthreads();
    if (threadIdx.x == 0) {
        unsigned* bar = b.bar;
        __builtin_amdgcn_s_waitcnt(0);
        unsigned nloc = b.st[0], nx = b.st[1];
        if (nloc == 0u) { xcd_barrier_complete(bar, b.x, nloc, nx); b.st[0] = nloc; b.st[1] = nx; }
        const unsigned old = xb_add(&bar[XB_XSUB(b.x)], 1u);
        const unsigned gen = old / nloc;
        if (old + 1u == (gen + 1u) * nloc) {
            __builtin_amdgcn_fence(__ATOMIC_RELEASE, "agent");
            asm volatile("s_waitcnt vmcnt(0)" ::: "memory");
            const unsigned og = xb_add(&bar[XB_TOP], 1u);
            const unsigned tg = og / nx;
            if (og + 1u == (tg + 1u) * nx) xb_add(&bar[XB_TOPGEN], 1u);
            else XB_SPIN(xb_ld(&bar[XB_TOPGEN]) == tg, bar);
            __builtin_amdgcn_fence(__ATOMIC_ACQUIRE, "agent");
            xb_add(&bar[XB_XGEN(b.x)], 1u);
            asm volatile("s_waitcnt vmcnt(0)" ::: "memory");
        } else {
            XB_SPIN(xb_ld(&bar[XB_XGEN(b.x)]) == gen, bar);
            __builtin_amdgcn_fence(__ATOMIC_ACQUIRE, "agent");
            asm volatile("s_waitcnt vmcnt(0)" ::: "memory");
        }
    }
    __syncthreads();
}


struct Args { const float* in[20]; const int* pos; float* out; unsigned char* ws; int ph_lo, ph_hi; };
template <class Epi>
__device__ __forceinline__ void run_gemm(LAS unsigned char* lds, const bf16* A, const bf16* Bt, int M, int N, int K, const Epi& E, int crot = 0) {
    pg8::Gemm g{A, Bt, M, N, K}; pg8::StaticOrder S; S.init(M, N, (int)gridDim.x, ((int)blockIdx.x + (int)gridDim.x - crot) % (int)gridDim.x);
    pg8::gemm_phase<Epi, pg8::StaticOrder, true, true>(lds, g, S, E);
}

__global__ void __launch_bounds__(NWAVES * 64, 2) fwd_mega(Args args) {
    extern __shared__ __attribute__((aligned(16))) unsigned char lds_raw[];
    LAS unsigned char* lds = (LAS unsigned char*)lds_raw;
    cg::grid_group grid = cg::this_grid();
    const int tid = threadIdx.x, lane = tid & 63, wave = __builtin_amdgcn_readfirstlane(tid >> 6);
    const int G = gridDim.x, c = blockIdx.x, gw = c * NWAVES + wave, NGW = G * NWAVES;
    unsigned char* ws = args.ws;
    const float* x = args.in[0]; const float* mem = args.in[1]; const int* positions = args.pos;
    float* out = args.out;
    float *ssq0 = (float*)(ws + WS_SSQ0), *ssq1 = (float*)(ws + WS_SSQ1), *ssq2 = (float*)(ws + WS_SSQ2), *ssq3 = (float*)(ws + WS_SSQ3);
    bf16* kmean = (bf16*)(ws + WS_KMEAN);
    bf16 *Wt_in = (bf16*)(ws + WS_WIN), *Wt_q = (bf16*)(ws + WS_WQ), *Wt_dsao = (bf16*)(ws + WS_WDSAO), *Wt_mobao = (bf16*)(ws + WS_WMOBAO), *Wt_out = (bf16*)(ws + WS_WOUT);
    bf16 *Wt_mq = (bf16*)(ws + WS_WMQ), *Wt_mkv = (bf16*)(ws + WS_WMKV), *Wt_mo = (bf16*)(ws + WS_WMO), *Wt_ff1 = (bf16*)(ws + WS_FF1), *Wt_ff2a = (bf16*)(ws + WS_FF2A), *Wt_ff2b = (bf16*)(ws + WS_FF2B);
    bf16 *memkv = (bf16*)(ws + WS_MEMKV), *memn = (bf16*)(ws + WS_MEMN);
    bf16 *hb = (bf16*)(ws + WS_H), *cq = (bf16*)(ws + WS_CQ), *ka = (bf16*)(ws + WS_KA), *va = (bf16*)(ws + WS_VA), *qb = (bf16*)(ws + WS_QB), *kb = (bf16*)(ws + WS_KB), *vb = (bf16*)(ws + WS_VB);
    bf16 *sga = (bf16*)(ws + WS_SGA), *sgb = (bf16*)(ws + WS_SGB); float* xres = (float*)(ws + WS_XRES);
    bf16 *kidx = (bf16*)(ws + WS_KIDX); float* widx = (float*)(ws + WS_WIDX);
    f32x2 *rope32 = (f32x2*)(ws + WS_ROPE32), *rope16 = (f32x2*)(ws + WS_ROPE16);
    bf16 *qa = (bf16*)(ws + WS_QA), *qidx = (bf16*)(ws + WS_QIDX), *odsa = (bf16*)(ws + WS_ODSA), *omoba = (bf16*)(ws + WS_OMOBA), *merged = (bf16*)(ws + WS_MERGED);
    bf16 *xb = (bf16*)(ws + WS_XB), *qm = (bf16*)(ws + WS_QM), *om = (bf16*)(ws + WS_OM), *ua = (bf16*)(ws + WS_UA);

    const int lo = args.ph_lo, hi = args.ph_hi;
#ifndef PH_MASK
#define PH_MASK 0x1FFFFF
#endif
#define IN(k) (((PH_MASK >> (k)) & 1) && lo <= (k) && (k) < hi)
    volatile LAS unsigned* xst = (volatile LAS unsigned*)(lds + LDS_BYTES - 16);
    if (tid == 0) { xst[0] = 0u; xst[1] = 0u; }
    __syncthreads();
    const XcdBarrier xbar = xcd_barrier_post((unsigned*)(ws + WS_BAR), xst);
#define GSYNC() xcd_barrier(xbar)
#define SEAM(k) do { if (IN(k) && ((k) == 3 ? IN(14) : IN((k) + 1))) { if ((k) == 0) grid.sync(); else GSYNC(); } } while (0)

#ifndef P0REPS
#define P0REPS 1
#endif
    if (IN(0)) for (int p0rep = 0; p0rep < P0REPS; ++p0rep) {
        LAS float* scr = (LAS float*)(lds + wave * 16384);
        constexpr int I_IN = 32 * 307, I_UQ = 8 * 32, I_DO = 16 * 64, I_OUT = 32 * 64, I_MQ = 32 * 16, I_MKV = 32 * 32, I_MO = 8 * 64;
        constexpr int NITEMS = I_IN + 2 * I_UQ + 2 * I_DO + I_OUT + I_MQ + I_MKV + I_MO;
        for (int it = gw; it < NITEMS; it += NGW) {
            int r = it;
            if (r < I_IN) { tr_item(args.in[4], 2048, 9808, Wt_in, 0, nullptr, 1, scr, r, lane); continue; } r -= I_IN;
            if (r < I_UQ) { tr_item(args.in[6], 512, 1024, Wt_q, 0, args.in[5], 0, scr, r, lane); continue; } r -= I_UQ;
            if (r < I_UQ) { tr_item(args.in[7], 512, 1024, Wt_q, 1024, args.in[5], 0, scr, r, lane); continue; } r -= I_UQ;
            if (r < I_DO) { tr_item(args.in[8], 1024, 2048, Wt_dsao, 0, nullptr, 0, scr, r, lane); continue; } r -= I_DO;
            if (r < I_DO) { tr_item(args.in[9], 1024, 2048, Wt_mobao, 0, nullptr, 0, scr, r, lane); continue; } r -= I_DO;
            if (r < I_OUT) { tr_item(args.in[10], 2048, 2048, Wt_out, 0, nullptr, 0, scr, r, lane); continue; } r -= I_OUT;
            if (r < I_MQ) { tr_item(args.in[13], 2048, 512, Wt_mq, 0, args.in[11], 0, scr, r, lane); continue; } r -= I_MQ;
            if (r < I_MKV) { tr_item(args.in[14], 2048, 1024, Wt_mkv, 0, nullptr, 0, scr, r, lane); continue; } r -= I_MKV;
            tr_item(args.in[15], 512, 2048, Wt_mo, 0, nullptr, 0, scr, r, lane);
        }
        for (int m = gw; m < T; m += NGW) rms_row_to_bf16(x + (size_t)m * DM, args.in[3], hb + (size_t)m * DM, lane);
        for (int m = gw; m < BATCH * 256; m += NGW) rms_row_to_bf16(mem + (size_t)m * DM, args.in[12], memn + (size_t)m * DM, lane);
        const int gt = c * 512 + tid, NGT = G * 512;
        for (int i = gt; i < T * 16; i += NGT) rope32[i] = rope_cs(positions[i >> 4], ROPE_INV[i & 15]);
        for (int i = gt; i < T * 8; i += NGT) rope16[i] = rope_cs(positions[i >> 3], ROPE_INV[2 * (i & 7)]);
        for (int i = gt; i < T; i += NGT) { ssq1[i] = 0.f; ssq2[i] = 0.f; ssq3[i] = 0.f; }
        __syncthreads();
    }
    SEAM(0);
#ifdef SYNCPROBE
    if (IN(1)) { for (int k = 0; k < 16; ++k) grid.sync(); }
#endif
#ifndef P1REPS
#define P1REPS 1
#endif
    if (IN(1)) { EpiIn E{cq, ka, va, qb, kb, vb, sga, sgb, kidx, widx, ssq0, rope32, rope16}; run_gemm(lds, hb, Wt_in, T, NIN, 2048, E);
#if P1REPS > 1
        run_gemm(lds, hb, Wt_in, T, NIN, 2048, E);
#endif
        { EpiPlain E2{memkv, 1024}; run_gemm(lds, memn, Wt_mkv, BATCH * 256, 1024, 2048, E2, G >= 256 ? 200 : 0); }
    }
    SEAM(1);
    if (IN(2)) {
        { EpiQ E{qa, qidx, ssq0, rope32, rope16}; run_gemm(lds, cq, Wt_q, T, 2048, 512, E); }
        for (int it = c; it < BATCH * 32 * 4; it += G) {
            const int blkid = it >> 2, cq4 = it & 3, cp = tid & 127, rq = tid >> 7;
            const unsigned* src = (const unsigned*)(kb + ((size_t)blkid * 256 + rq * 64) * 1024 + cq4 * 256) + cp; float s0 = 0.f, s1 = 0.f;
#pragma unroll 16
            for (int r = 0; r < 64; ++r) { const unsigned u = src[(size_t)r * 512]; s0 += bflo(u); s1 += bfhi(u); }
            LAS float* red = (LAS float*)lds;
            __syncthreads();
            red[(rq * 128 + cp) * 2] = s0; red[(rq * 128 + cp) * 2 + 1] = s1;
            __syncthreads();
            if (rq == 0) { float a0 = 0.f, a1 = 0.f;
#pragma unroll
                for (int k = 0; k < 4; ++k) { a0 += red[(k * 128 + cp) * 2]; a1 += red[(k * 128 + cp) * 2 + 1]; }
                ((unsigned*)(kmean + (size_t)blkid * 1024 + cq4 * 256))[cp] = cvt_pk_bf16(a0 * (1.f / 256.f), a1 * (1.f / 256.f)); }
        }
        __syncthreads();
    }
    SEAM(2);
    unsigned short* selg = (unsigned short*)(ws + WS_SELG);
    if (IN(3)) {
        float* scr = (float*)(ws + WS_SCR + (size_t)c * 262144);
#ifndef SELREPS
#define SELREPS 1
#endif
#ifndef MOBAREPS
#define MOBAREPS 1
#endif
#ifndef ATTREPS
#define ATTREPS 1
#endif
        for (int i = 0;; ++i) { int L = i * G + ((i & 1) ? G - 1 - c : c); if (L >= 2048 * SELREPS) break; L &= 2047;
            const int b = L & 1, t0 = (1023 - (L >> 1)) * 8;
            dsa_group(lds, b, t0, scr, qidx, kidx, widx, selg);
            __syncthreads(); }
        for (int i = 0;; ++i) { const int L = i * G + ((i & 1) ? G - 1 - c : c); if (L >= 512) break;
            const int qt = 31 - (L >> 4), bh = L & 15, b = bh >> 3, h = bh & 7, cur = qt, s0 = qt * 256;
            const size_t tok0 = (size_t)b * SEQ + s0, kb0 = (size_t)b * SEQ;
            attn_unit<true>(lds, qb + tok0 * 1024 + h * 128, 1024, kb + kb0 * 1024 + h * 128, 1024, vb + kb0 * 1024 + h * 128, 1024, omoba + tok0 * 1024 + h * 128, 1024,
                            cur, s0, kmean + (size_t)b * 32 * 1024 + h * 128); }
    }
    SEAM(3);
    if (IN(14)) {
        const int hx = c & 7, nxb = (G - hx + 7) >> 3, wx = (c >> 3) * NWAVES + wave, nwx = nxb * NWAVES;
        bf16* pg = (bf16*)(ws + WS_SCR);
        for (int b = 0; b < BATCH; ++b) {
            for (int t = wx; t < SEQ; t += nwx) dsa_qk_item(lds, wave, lane, b, t, hx, selg, qa, ka, pg);
            for (int t = wx; t < SEQ; t += nwx) dsa_pv_item(lds, wave, lane, b, t, hx, selg, pg, va, odsa);
        }
    }
    if (IN(14) && IN(4)) GSYNC();
    if (IN(4)) {
#if defined(NO_DSA)
        { EpiMerge<true> E{merged, sgb}; run_gemm(lds, omoba, Wt_mobao, T, 2048, 1024, E); }
#else
        { EpiMerge<true> E{merged, sga}; run_gemm(lds, odsa, Wt_dsao, T, 2048, 1024, E); }
#ifndef NO_MOBA
        { EpiMerge<false> E{merged, sgb}; run_gemm(lds, omoba, Wt_mobao, T, 2048, 1024, E); }
#endif
#endif
    }
    SEAM(4);
    if (IN(5)) { EpiRes E{x, xres, xb, ssq1}; run_gemm(lds, merged, Wt_out, T, 2048, 2048, E); }
    SEAM(5);
    if (IN(6)) {
        LAS float* scr = (LAS float*)(lds + wave * 16384);
        constexpr int I_F1 = 32 * 256, I_F2H = 64 * 64;
        for (int it = gw; it < I_F1 + 2 * I_F2H; it += NGW) { int r = it;
            if (r < I_F1) { tr_item(args.in[17], 2048, 8192, Wt_ff1, 0, args.in[16], 0, scr, r, lane); continue; } r -= I_F1;
            if (r < I_F2H) { tr_item(args.in[18], 4096, 2048, Wt_ff2a, 0, nullptr, 0, scr, r, lane); continue; } r -= I_F2H;
            tr_item(args.in[18] + (size_t)4096 * 2048, 4096, 2048, Wt_ff2b, 0, nullptr, 0, scr, r, lane); }
        __syncthreads();
        EpiNormed<0> E{qm, 512, ssq1, QSCALE}; run_gemm(lds, xb, Wt_mq, T, 512, 2048, E);
    }
    SEAM(6);
    if (IN(7)) {
        for (int L = c; L < 256; L += G) { const int h = L & 3, qt = L >> 2, b = qt >> 5; const size_t tok0 = (size_t)qt * 256;
            attn_unit<false>(lds, qm + tok0 * 512 + h * 128, 512, memkv + (size_t)b * 256 * 1024 + h * 128, 1024, memkv + (size_t)b * 256 * 1024 + 512 + h * 128, 1024,
                             om + tok0 * 512 + h * 128, 512, 4, 0, nullptr); }
    }
    SEAM(7);
    if (IN(8)) { EpiRes E{xres, xres, xb, ssq2}; run_gemm(lds, om, Wt_mo, T, 2048, 512, E); }
    SEAM(8);
    if (IN(9)) { EpiNormed<1> E{ua, 4096, ssq2, 1.f}; run_gemm(lds, xb, Wt_ff1, T, 4096, 2048, E); }
    SEAM(9);
    if (IN(10)) { EpiRes E{xres, xres, nullptr, nullptr}; run_gemm(lds, ua, Wt_ff2a, T, 2048, 4096, E); }
    SEAM(10);
    if (IN(11)) { EpiNormed<1> E{ua, 4096, ssq2, 1.f}; run_gemm(lds, xb, Wt_ff1 + (size_t)4096 * 2048, T, 4096, 2048, E); }
    SEAM(11);
    if (IN(12)) { EpiRes E{xres, xres, nullptr, ssq3}; run_gemm(lds, ua, Wt_ff2b, T, 2048, 4096, E); }
    SEAM(12);
    if (IN(13)) {
        const f32x4* gr = (const f32x4*)args.in[19] + lane;
        for (int m = gw; m < T; m += NGW) { const f32x4* xr = (const f32x4*)(xres + (size_t)m * DM) + lane; f32x4* orow = (f32x4*)(out + (size_t)m * DM) + lane;
            const float rstd = 1.f / sqrtf(ssq3[m] * (1.f / 2048.f) + EPS);
#pragma unroll
            for (int j = 0; j < 8; ++j) { const f32x4 v = xr[64 * j], gv = gr[64 * j]; orow[64 * j] = v * rstd * gv; } }
    }
#ifdef DUMP_PHASE
    if (IN(20)) {
        const int gt = c * 512 + tid, NGT = G * 512;
        for (size_t i = gt; i < (size_t)T * 2048; i += NGT) { const size_t m = i >> 11; const int cc = (int)(i & 2047); float v = 0.f;
#if DUMP_PHASE == 1
            if (cc < 1024) v = bflo(ka[m * 1024 + cc]) + bflo(va[m * 1024 + cc]) * 2.f + bflo(qb[m * 1024 + cc]) * 3.f + bflo(kb[m * 1024 + cc]) * 4.f + bflo(vb[m * 1024 + cc]) * 5.f;
            else v = bflo(cq[m * 512 + (cc & 511)]) + bflo(kidx[m * 64 + (cc & 63)]) * 2.f + widx[m * 16 + (cc & 15)] * 3.f + ssq0[m * 8 + (cc & 7)];
#elif DUMP_PHASE == 11
            v = bflo(sga[i]) + 2.f * bflo(sgb[i]);
#elif DUMP_PHASE == 2
            if (cc < 1024) v = bflo(qa[m * 1024 + cc]); else v = bflo(qidx[m * 1024 + cc - 1024]);
            v += bflo(kmean[i & 65535]) + bflo(memkv[i & 524287]);
#elif DUMP_PHASE == 3
            if (cc < 1024) v = bflo(odsa[m * 1024 + cc]); else v = bflo(omoba[m * 1024 + cc - 1024]);
#elif DUMP_PHASE == 4
            v = bflo(merged[i]);
#endif
            out[i] = v; }
    }
#endif
#undef IN
#undef SEAM
}

extern "C" void kernel_launch(void* const* d_in, const int* in_sizes, int n_in, void* d_out, int out_size, void* d_ws, size_t ws_size, hipStream_t stream) {
    static int grid = 0;
    if (grid == 0) {
        if (n_in != 20 || out_size != T * DM || ws_size < WS_END) { fprintf(stderr, "kernel_launch: unexpected shapes (n_in %d, out %d, ws %zu)\n", n_in, out_size, ws_size); grid = -1; return; }
        int dev = 0, cus = 0, per_cu = 0;
        (void)hipGetDevice(&dev); (void)hipDeviceGetAttribute(&cus, hipDeviceAttributeMultiprocessorCount, dev);
        if (hipFuncSetAttribute((const void*)fwd_mega, hipFuncAttributeMaxDynamicSharedMemorySize, LDS_BYTES) != hipSuccess) { fprintf(stderr, "kernel_launch: hipFuncSetAttribute failed\n"); grid = -1; return; }
        if (hipOccupancyMaxActiveBlocksPerMultiprocessor(&per_cu, (const void*)fwd_mega, NWAVES * 64, LDS_BYTES) != hipSuccess || per_cu < 1) { fprintf(stderr, "kernel_launch: occupancy query gave %d\n", per_cu); per_cu = 1; }
        (void)hipGetLastError();
        grid = cus * per_cu; if (grid > 256) grid = 256; if (grid < 1) grid = 256;
    }
    if (grid < 0) return;
    Args a{};
    for (int i = 0; i < 20; ++i) a.in[i] = (const float*)d_in[i];
    a.pos = (const int*)d_in[2]; a.out = (float*)d_out; a.ws = (unsigned char*)d_ws;
#if ONE_LAUNCH
    (void)hipMemsetAsync(d_ws, 0, 16384, stream);
    a.ph_lo = 0; a.ph_hi = 15;
    void* kargs[] = {&a};
    hipError_t e = hipLaunchCooperativeKernel((const void*)fwd_mega, dim3(grid), dim3(NWAVES * 64), kargs, LDS_BYTES, stream);
    if (e != hipSuccess) fprintf(stderr, "kernel_launch: cooperative launch failed: %s (grid %d)\n", hipGetErrorString(e), grid);
#else
#ifdef DUMP_PHASE
    for (int ph = 0; ph <= (DUMP_PHASE == 11 ? 1 : DUMP_PHASE); ++ph) { a.ph_lo = ph; a.ph_hi = ph + 1; hipLaunchKernelGGL(fwd_mega, dim3(grid), dim3(NWAVES * 64), LDS_BYTES, stream, a); }
    a.ph_lo = 20; a.ph_hi = 21; hipLaunchKernelGGL(fwd_mega, dim3(grid), dim3(NWAVES * 64), LDS_BYTES, stream, a);
#else
    for (int ph = 0; ph < NPH; ++ph) { a.ph_lo = ph; a.ph_hi = ph + 1; hipLaunchKernelGGL(fwd_mega, dim3(grid), dim3(NWAVES * 64), LDS_BYTES, stream, a); }
#endif
#endif
}
```

```cpp
#include <hip/hip_runtime.h>
#include <hip/hip_cooperative_groups.h>
#include <cstdio>
#include <cstdint>
namespace cg = cooperative_groups;
#ifndef ONE_LAUNCH
#define ONE_LAUNCH 1
#endif
namespace pg8 {
#define PG8_LAS __attribute__((address_space(3)))
typedef unsigned short bf16_t;
typedef short bf16x8 __attribute__((ext_vector_type(8)));
typedef float f32x4 __attribute__((ext_vector_type(4)));
typedef unsigned u32x4 __attribute__((ext_vector_type(4)));
constexpr int BM = 256, BK = 64, HALF = 128, HTB = HALF * BK * 2  , STAGE_BYTES = 8 * HTB, NXCD = 8, WGM = 8;

__host__ __device__ __forceinline__ int lds_byte(int r, int c) { const int st = (r >> 4) * 2 + (c >> 5), rr = r & 15, cc = c & 31, ob = rr * 64 + cc * 2; return st * 1024 + (ob ^ (((ob >> 9) & 1) << 5)); }
__host__ __device__ __forceinline__ void stage_rc(int b, int& R, int& C) { const int st = b / 1024, sb = b % 1024, swz = sb ^ (((sb >> 9) & 1) << 5); R = (st >> 1) * 16 + swz / 64; C = (st & 1) * 32 + (swz % 64) / 2; }
__host__ __device__ __forceinline__ int perm32(int rho) { const int n = rho >> 4, i = rho & 15; return 8 * (i >> 2) + 4 * n + (i & 3); }

struct Unit { int pm, pn; };
struct Gemm { const bf16_t* A; const bf16_t* Bt; int M, N, K; };

struct StaticOrder {
    int nM, nN, nwg, G, c;
    __host__ __device__ void init(int M, int N, int G_, int c_) { nM = M / BM; nN = N / BM; nwg = nM * nN; G = G_; c = c_; }
    __host__ __device__ bool next(int i, Unit& u) const {
        const long L = (long)i * G + c; if (L >= nwg) return false;
        int wgid = (int)L; { const int q = nwg / NXCD, r = nwg % NXCD, xcd = wgid % NXCD, off = wgid / NXCD; wgid = (xcd < r ? xcd * (q + 1) : r * (q + 1) + (xcd - r) * q) + off; }
        const int nig = WGM * nN, gid = wgid / nig, fm = gid * WGM, gsz = (nM - fm) < WGM ? (nM - fm) : WGM;
        u.pm = fm + ((wgid % nig) % gsz); u.pn = (wgid % nig) / gsz; return true;
    }
    __device__ __forceinline__ void a_ready(const Unit&) const {}
    __device__ __forceinline__ void done(const Unit&) const {}
};
__device__ __forceinline__ unsigned cvt_pk_bf16(float lo, float hi) { unsigned r; asm volatile("v_cvt_pk_bf16_f32 %0, %1, %2" : "=v"(r) : "v"(lo), "v"(hi)); return r; }
template <class Epi, class Sched, bool ALIGN_EPI = false, bool SP2 = false>
__device__ __forceinline__ void gemm_phase(PG8_LAS unsigned char* lds, const Gemm g, const Sched& S, const Epi& E) {
    const int tid = threadIdx.x, wid = __builtin_amdgcn_readfirstlane(tid >> 6), lane = tid & 63, wr = wid >> 2, wc = wid & 3, fr = lane & 15, fq = lane >> 4;
    const int K = g.K, nt = K / BK;
    unsigned voffA[2], voffB[2];
#pragma unroll
    for (int i = 0; i < 2; ++i) { int R, C; stage_rc(tid * 16 + i * 8192, R, C); const int Rb = Epi::PERM ? ((R & ~31) + perm32(R & 31)) : R;
        voffA[i] = (unsigned)(R * K + C) * 2u; voffB[i] = (unsigned)(Rb * K + C) * 2u; }
    const size_t kstep = (size_t)(BK * 2);
    const size_t hstep = (size_t)HALF * K * 2;
    const size_t tstep = 2 * hstep;
    const unsigned ldsw = (unsigned)wid * 1024u;
    const int aoff = lds_byte(wr * 64 + fr, fq * 8), boff = lds_byte(wc * 32 + fr, fq * 8);
#define PG8_SA(b, h) (((b) * 2 + (h)) * HTB)
#define PG8_SB(b, h) ((4 + (b) * 2 + (h)) * HTB)
#define PG8_STAGE(bufoff, gbase, voff) do { _Pragma("unroll") for (int _i = 0; _i < 2; ++_i) \
        __builtin_amdgcn_global_load_lds((const unsigned*)((const char*)(gbase) + (voff)[_i]), (PG8_LAS unsigned*)(lds + (bufoff) + ldsw + _i * 8192), 16, 0, 0); } while (0)
#define PG8_LDA(dst, b, h) do { _Pragma("unroll") for (int m = 0; m < 4; ++m) _Pragma("unroll") for (int k = 0; k < 2; ++k) dst[m][k] = *(const PG8_LAS bf16x8*)(lds + PG8_SA(b, h) + aoff + m * 2048 + k * 1024); } while (0)
#define PG8_LDB(dst, b, h) do { _Pragma("unroll") for (int n = 0; n < 2; ++n) _Pragma("unroll") for (int k = 0; k < 2; ++k) dst[n][k] = *(const PG8_LAS bf16x8*)(lds + PG8_SB(b, h) + boff + n * 2048 + k * 1024); } while (0)
#define PG8_MMA(ai, bj, At, Bt) do { __builtin_amdgcn_s_setprio(1); _Pragma("unroll") for (int m = 0; m < 4; ++m) _Pragma("unroll") for (int n = 0; n < 2; ++n) _Pragma("unroll") for (int k = 0; k < 2; ++k) \
        acc[ai][bj][m][n] = __builtin_amdgcn_mfma_f32_16x16x32_bf16(Bt[n][k], At[m][k], acc[ai][bj][m][n], 0, 0, 0); __builtin_amdgcn_s_setprio(0); } while (0)
#define PG8_WAIT_V(n) asm volatile("s_waitcnt vmcnt(" #n ")" ::: "memory")
#define PG8_WAIT_L(n) asm volatile("s_waitcnt lgkmcnt(" #n ")" ::: "memory")
#define PG8_BAR __builtin_amdgcn_s_barrier()
#define PG8_SCHED __builtin_amdgcn_sched_barrier(0)
    Unit cur, nxt; int ui = 0;
    if (!S.next(0, cur)) return;
    f32x4 acc[2][2][4][2];
#pragma unroll
    for (int a = 0; a < 2; ++a)
#pragma unroll
        for (int b = 0; b < 2; ++b)
#pragma unroll
            for (int m = 0; m < 4; ++m)
#pragma unroll
                for (int n = 0; n < 2; ++n) acc[a][b][m][n] = (f32x4){0.f, 0.f, 0.f, 0.f};
    bf16x8 At[4][2], B0[2][2], B1[2][2];
    const char* cA = (const char*)g.A + (size_t)cur.pm * tstep; const char* cB = (const char*)g.Bt + (size_t)cur.pn * tstep;
    S.a_ready(cur);
    if constexpr (SP2) {
        PG8_STAGE(PG8_SB(0, 0), cB, voffB); PG8_STAGE(PG8_SB(0, 1), cB + hstep, voffB); PG8_STAGE(PG8_SA(0, 0), cA, voffA); PG8_STAGE(PG8_SA(0, 1), cA + hstep, voffA);
        if (wr == 1) PG8_BAR;
        PG8_WAIT_V(2); PG8_BAR;
        PG8_STAGE(PG8_SB(1, 0), cB + kstep, voffB); PG8_STAGE(PG8_SA(1, 0), cA + kstep, voffA); PG8_STAGE(PG8_SB(1, 1), cB + hstep + kstep, voffB);
        PG8_WAIT_V(6); PG8_BAR;
    } else {
        PG8_STAGE(PG8_SB(0, 0), cB, voffB); PG8_STAGE(PG8_SA(0, 0), cA, voffA); PG8_STAGE(PG8_SB(0, 1), cB + hstep, voffB); PG8_STAGE(PG8_SA(0, 1), cA + hstep, voffA);
        if (wr == 1) PG8_BAR;
        PG8_WAIT_V(4); PG8_BAR;
        PG8_STAGE(PG8_SB(1, 0), cB + kstep, voffB); PG8_STAGE(PG8_SA(1, 0), cA + kstep, voffA); PG8_STAGE(PG8_SB(1, 1), cB + hstep + kstep, voffB);
        PG8_WAIT_V(6); PG8_BAR;
    }
    for (;;) {
        const bool has_next = S.next(ui + 1, nxt);
        const char* nA = has_next ? (const char*)g.A + (size_t)nxt.pm * tstep : cA; const char* nB = has_next ? (const char*)g.Bt + (size_t)nxt.pn * tstep : cB;
        for (int t = 0; t < nt; t += 2) {
            const bool last = (t == nt - 2);
            const char* a1 = cA + (size_t)(t + 1) * kstep;
            const char* a2 = last ? nA : cA + (size_t)(t + 2) * kstep; const char* b2 = last ? nB : cB + (size_t)(t + 2) * kstep;
            const char* a3 = a2 + kstep; const char* b3 = b2 + kstep;
            if (last && has_next) S.a_ready(nxt);
            if constexpr (SP2) {
            PG8_LDB(B0, 0, 0); PG8_LDB(B1, 0, 1); PG8_SCHED; PG8_LDA(At, 0, 0); PG8_STAGE(PG8_SA(1, 1), a1 + hstep, voffA);
            PG8_WAIT_V(8); PG8_WAIT_L(0); PG8_BAR; PG8_MMA(0, 0, At, B0); PG8_MMA(0, 1, At, B1); PG8_BAR; PG8_SCHED;
            PG8_LDA(At, 0, 1); PG8_STAGE(PG8_SB(0, 0), b2, voffB); PG8_STAGE(PG8_SB(0, 1), b2 + hstep, voffB); PG8_STAGE(PG8_SA(0, 0), a2, voffA);
            PG8_WAIT_V(8); PG8_WAIT_L(0); PG8_BAR; PG8_MMA(1, 0, At, B0); PG8_MMA(1, 1, At, B1); PG8_BAR; PG8_SCHED;
            PG8_LDB(B0, 1, 0); PG8_LDB(B1, 1, 1); PG8_SCHED; PG8_LDA(At, 1, 0); PG8_STAGE(PG8_SA(0, 1), a2 + hstep, voffA);
            PG8_WAIT_V(8); PG8_WAIT_L(0); PG8_BAR; PG8_MMA(0, 0, At, B0); PG8_MMA(0, 1, At, B1); PG8_BAR; PG8_SCHED;
            PG8_LDA(At, 1, 1); PG8_STAGE(PG8_SB(1, 0), b3, voffB); PG8_STAGE(PG8_SB(1, 1), b3 + hstep, voffB); PG8_STAGE(PG8_SA(1, 0), a3, voffA);
            PG8_WAIT_V(8); PG8_WAIT_L(0); PG8_BAR; PG8_MMA(1, 0, At, B0); PG8_MMA(1, 1, At, B1); PG8_BAR; PG8_SCHED;
            } else {
            PG8_LDB(B0, 0, 0); PG8_SCHED; PG8_LDA(At, 0, 0); PG8_STAGE(PG8_SA(1, 1), a1 + hstep, voffA);
            PG8_WAIT_L(8); PG8_BAR; PG8_WAIT_L(0); PG8_MMA(0, 0, At, B0); PG8_BAR; PG8_SCHED;
            PG8_LDB(B1, 0, 1); PG8_STAGE(PG8_SB(0, 0), b2, voffB);
            PG8_BAR; PG8_WAIT_L(0); PG8_MMA(0, 1, At, B1); PG8_BAR;
            PG8_LDA(At, 0, 1); PG8_STAGE(PG8_SA(0, 0), a2, voffA);
            PG8_BAR; PG8_WAIT_L(0); PG8_MMA(1, 0, At, B0); PG8_BAR; PG8_SCHED;
            PG8_STAGE(PG8_SB(0, 1), b2 + hstep, voffB);
            PG8_WAIT_V(6); PG8_BAR; PG8_MMA(1, 1, At, B1); PG8_BAR;
            PG8_LDB(B0, 1, 0); PG8_SCHED; PG8_LDA(At, 1, 0); PG8_STAGE(PG8_SA(0, 1), a2 + hstep, voffA);
            PG8_WAIT_L(8); PG8_BAR; PG8_WAIT_L(0); PG8_MMA(0, 0, At, B0); PG8_BAR; PG8_SCHED;
            PG8_LDB(B1, 1, 1); PG8_STAGE(PG8_SB(1, 0), b3, voffB);
            PG8_BAR; PG8_WAIT_L(0); PG8_MMA(0, 1, At, B1); PG8_BAR;
            PG8_LDA(At, 1, 1); PG8_STAGE(PG8_SA(1, 0), a3, voffA);
            PG8_BAR; PG8_WAIT_L(0); PG8_MMA(1, 0, At, B0); PG8_BAR; PG8_SCHED;
            PG8_STAGE(PG8_SB(1, 1), b3 + hstep, voffB);
            PG8_WAIT_V(6); PG8_BAR; PG8_MMA(1, 1, At, B1); PG8_BAR;
            }
        }
        if constexpr (ALIGN_EPI) { if (wr == 0) PG8_BAR; }
        if constexpr (!Epi::AFTER_DRAIN) { E(acc, cur, wr, wc, fr, fq); S.done(cur); }
        if (!has_next) break;
#pragma unroll
        for (int a = 0; a < 2; ++a)
#pragma unroll
            for (int b = 0; b < 2; ++b)
#pragma unroll
                for (int m = 0; m < 4; ++m)
#pragma unroll
                    for (int n = 0; n < 2; ++n) acc[a][b][m][n] = (f32x4){0.f, 0.f, 0.f, 0.f};
        cur = nxt; cA = nA; cB = nB; ++ui;
        if constexpr (ALIGN_EPI) { if (wr == 1) PG8_BAR; }
    }
    PG8_WAIT_V(0);
    if constexpr (!ALIGN_EPI) { if (wr == 0) PG8_BAR; }
    PG8_BAR;
    if constexpr (Epi::AFTER_DRAIN) { E.fused(acc, cur, wr, wc, fr, fq, lds, wid, lane); S.done(cur); }
#undef PG8_SA
#undef PG8_SB
#undef PG8_STAGE
#undef PG8_LDA
#undef PG8_LDB
#undef PG8_MMA
#undef PG8_WAIT_V
#undef PG8_WAIT_L
#undef PG8_BAR
#undef PG8_SCHED
}
}

#define GAS __attribute__((address_space(1)))
#define LAS __attribute__((address_space(3)))
typedef unsigned short bf16;
typedef unsigned v4u __attribute__((ext_vector_type(4)));
typedef unsigned v2u __attribute__((ext_vector_type(2)));
typedef float f32x4 __attribute__((ext_vector_type(4)));
typedef float f32x2 __attribute__((ext_vector_type(2)));
typedef short bf16x8 __attribute__((ext_vector_type(8)));
using pg8::Unit;
typedef __bf16 bf16x2_t __attribute__((ext_vector_type(2)));
__device__ __forceinline__ unsigned cvt_pk_bf16(float lo, float hi) { f32x2 v = {lo, hi}; bf16x2_t b = __builtin_convertvector(v, bf16x2_t); return __builtin_bit_cast(unsigned, b); }
#define LDS_WAIT() asm volatile("s_waitcnt lgkmcnt(0)" ::: "memory")

constexpr int BATCH = 2, SEQ = 8192, T = BATCH * SEQ, DM = 2048, NIN = 9984, DFF = 8192;
constexpr float EPS = 1e-6f;
constexpr float LOG2E = 1.4426950408889634f;
constexpr float QSCALE = 0.08838834764831845f * LOG2E;
constexpr int NWAVES = 8;
constexpr int LDS_BYTES = 147456;
constexpr int NPH = 14;

constexpr size_t MiB = 1u << 20;
constexpr size_t WS_BAR = 0, WS_SSQ1 = 65536, WS_SSQ2 = 131072, WS_SSQ3 = 196608, WS_KMEAN = 262144;
constexpr size_t WS_WQ = 1 * MiB, WS_WDSAO = 3 * MiB, WS_WMOBAO = 7 * MiB, WS_WOUT = 11 * MiB, WS_WMQ = 19 * MiB, WS_WMKV = 21 * MiB, WS_WMO = 25 * MiB, WS_MEMKV = 27 * MiB, WS_MEMN = 28 * MiB;
constexpr size_t WS_H = 30 * MiB, WS_QA = 30 * MiB, WS_ODSA = WS_QA  , WS_QIDX = 62 * MiB;
constexpr size_t WS_FF1 = 30 * MiB, WS_FF2A = 62 * MiB, WS_FF2B = 78 * MiB;
constexpr size_t WS_WIN = 94 * MiB, WS_CQ = 133 * MiB, WS_ROPE32 = 149 * MiB, WS_ROPE16 = 151 * MiB, WS_KIDX = 152 * MiB, WS_WIDX = 154 * MiB, WS_SSQ0 = 155 * MiB;
constexpr size_t WS_SCR = 156 * MiB, WS_SELG = 94 * MiB;
constexpr size_t WS_KA = 220 * MiB, WS_VA = 252 * MiB, WS_MERGED = 220 * MiB;
constexpr size_t WS_QB = 284 * MiB, WS_OMOBA = WS_QB  , WS_KB = 316 * MiB, WS_VB = 348 * MiB;
constexpr size_t WS_XB = 284 * MiB, WS_QM = 348 * MiB, WS_OM = 364 * MiB;
constexpr size_t WS_SGA = 380 * MiB, WS_SGB = 444 * MiB, WS_XRES = 380 * MiB;
constexpr size_t WS_UA = 94 * MiB, WS_END = 512 * MiB;

__device__ __forceinline__ float wave_sum(float v) {
#pragma unroll
    for (int o = 1; o < 64; o <<= 1) v += __shfl_xor(v, o);
    return v;
}
__device__ __forceinline__ int wave_sum_i(int v) {
    v += __builtin_amdgcn_update_dpp(0, v, 0xB1, 0xf, 0xf, false);
    v += __builtin_amdgcn_update_dpp(0, v, 0x4E, 0xf, 0xf, false);
    v += __builtin_amdgcn_update_dpp(0, v, 0x141, 0xf, 0xf, false);
    v += __builtin_amdgcn_update_dpp(0, v, 0x140, 0xf, 0xf, false);
    return __builtin_amdgcn_readlane(v, 0) + __builtin_amdgcn_readlane(v, 16) + __builtin_amdgcn_readlane(v, 32) + __builtin_amdgcn_readlane(v, 48);
}
__device__ __forceinline__ float bflo(unsigned u) { return __builtin_bit_cast(float, u << 16); }
__device__ __forceinline__ float bfhi(unsigned u) { return __builtin_bit_cast(float, u & 0xffff0000u); }
__device__ __forceinline__ float fexp2(float x) { return __builtin_amdgcn_exp2f(x); }

typedef const pg8::f32x4 (&AccRef)[2][2][4][2];

typedef _Float16 h2_t __attribute__((ext_vector_type(2)));
__device__ __forceinline__ unsigned cvt_pk_f16(float lo, float hi) { f32x2 v = {lo, hi}; h2_t h = __builtin_convertvector(v, h2_t); return __builtin_bit_cast(unsigned, h); }
__device__ __forceinline__ v4u pack8h(const float* v) { v4u w; w.x = cvt_pk_f16(v[0], v[1]); w.y = cvt_pk_f16(v[2], v[3]); w.z = cvt_pk_f16(v[4], v[5]); w.w = cvt_pk_f16(v[6], v[7]); return w; }
__device__ __forceinline__ float hdot2(unsigned a, unsigned b, float c) { return __builtin_amdgcn_fdot2(__builtin_bit_cast(h2_t, a), __builtin_bit_cast(h2_t, b), c, false); }
__device__ __forceinline__ v4u pack8(const float* v) { v4u w; w.x = cvt_pk_bf16(v[0], v[1]); w.y = cvt_pk_bf16(v[2], v[3]); w.z = cvt_pk_bf16(v[4], v[5]); w.w = cvt_pk_bf16(v[6], v[7]); return w; }

__device__ __forceinline__ void rope_head128(float* v, const f32x2* cs  , int fq) {
#pragma unroll
    for (int e = 0; e < 8; ++e) { const float o = __shfl_xor(v[e], 32); const f32x2 c = cs[e]; v[e] = v[e] * c.x + (fq < 2 ? -o : o) * c.y; }
}
__device__ __forceinline__ void rope_head64(float* v, const f32x2* cs  , int fq) {
#pragma unroll
    for (int e = 0; e < 8; ++e) { const float o = __shfl_xor(v[e], 16); const f32x2 c = cs[e]; const float r = v[e] * c.x + (fq == 0 ? -o : o) * c.y; if (fq < 2) v[e] = r; }
}

struct EpiIn {
    static constexpr bool PERM = true, AFTER_DRAIN = false;
    bf16 *cq, *ka, *va, *qb, *kb, *vb, *sga, *sgb, *kidx; float* widx; float* ssq0; const f32x2* rope32; const f32x2* rope16;
    __device__ __forceinline__ void operator()(AccRef acc, const Unit& u, int wr, int wc, int fr, int fq) const {
        const int pn = u.pn, row0 = u.pm * 256 + wr * 64 + fr, cl = wc * 32 + 8 * fq;
        if (pn < 2) {
#pragma unroll
            for (int ai = 0; ai < 2; ++ai)
#pragma unroll
                for (int m = 0; m < 4; ++m) { const int row = row0 + ai * 128 + m * 16; float ss = 0.f;
#pragma unroll
                    for (int bj = 0; bj < 2; ++bj) { float v[8];
#pragma unroll
                        for (int e = 0; e < 8; ++e) { v[e] = acc[ai][bj][m][e >> 2][e & 3]; ss += v[e] * v[e]; }
                        *(v4u*)(cq + (size_t)row * 512 + pn * 256 + bj * 128 + cl) = pack8(v); }
                    ss += __shfl_xor(ss, 16); ss += __shfl_xor(ss, 32);
                    if (fq == 0) ssq0[(size_t)row * 8 + pn * 4 + wc] = ss; }
        } else if (pn < 22) {
            const int sec = (pn - 2) >> 2, colb = ((pn - 2) & 3) * 256;
            bf16* base = sec == 0 ? ka : sec == 1 ? va : sec == 2 ? qb : sec == 3 ? kb : vb;
            const bool rope = (sec != 1 && sec != 4) && (wc == 0);
            const float sc = sec == 2 ? QSCALE : 1.f;
#pragma unroll
            for (int ai = 0; ai < 2; ++ai)
#pragma unroll
                for (int m = 0; m < 4; ++m) { const int row = row0 + ai * 128 + m * 16;
#pragma unroll
                    for (int bj = 0; bj < 2; ++bj) { float v[8];
#pragma unroll
                        for (int e = 0; e < 8; ++e) v[e] = acc[ai][bj][m][e >> 2][e & 3];
                        if (rope) rope_head128(v, rope32 + (size_t)row * 16 + 8 * (fq & 1), fq);
#pragma unroll
                        for (int e = 0; e < 8; ++e) v[e] *= sc;
                        *(v4u*)(base + (size_t)row * 1024 + colb + bj * 128 + cl) = sec < 2 ? pack8h(v) : pack8(v); } }
        } else if (pn < 38) {
            const int g = pn - 22; bf16* base = g < 8 ? sga : sgb; const int colb = (g & 7) * 256;
#pragma unroll
            for (int ai = 0; ai < 2; ++ai)
#pragma unroll
                for (int m = 0; m < 4; ++m) { const int row = row0 + ai * 128 + m * 16;
#pragma unroll
                    for (int bj = 0; bj < 2; ++bj) { float v[8];
#pragma unroll
                        for (int e = 0; e < 8; ++e) { const float x = acc[ai][bj][m][e >> 2][e & 3]; v[e] = __builtin_amdgcn_rcpf(1.f + fexp2(-LOG2E * x)); }
                        *(v4u*)(base + (size_t)row * 2048 + colb + bj * 128 + cl) = pack8(v); } }
        } else {
            if (wc < 2) {
#pragma unroll
                for (int ai = 0; ai < 2; ++ai)
#pragma unroll
                    for (int m = 0; m < 4; ++m) { const int row = row0 + ai * 128 + m * 16; float v[8];
#pragma unroll
                        for (int e = 0; e < 8; ++e) v[e] = acc[ai][0][m][e >> 2][e & 3];
                        if (wc == 0) rope_head64(v, rope16 + (size_t)row * 8, fq);
                        *(v4u*)(kidx + (size_t)row * 64 + cl) = pack8(v); }
            } else if (wc == 2 && fq < 2) {
#pragma unroll
                for (int ai = 0; ai < 2; ++ai)
#pragma unroll
                    for (int m = 0; m < 4; ++m) { const int row = row0 + ai * 128 + m * 16;
                        *(f32x4*)(widx + (size_t)row * 16 + 8 * fq) = acc[ai][0][m][0] * 0.03125f;
                        *(f32x4*)(widx + (size_t)row * 16 + 8 * fq + 4) = acc[ai][0][m][1] * 0.03125f; }
            }
        }
    }
};

struct EpiQ {
    static constexpr bool PERM = true, AFTER_DRAIN = false;
    bf16 *qa, *qidx; const float* ssq0; const f32x2* rope32; const f32x2* rope16;
    __device__ __forceinline__ void operator()(AccRef acc, const Unit& u, int wr, int wc, int fr, int fq) const {
        const int pn = u.pn, row0 = u.pm * 256 + wr * 64 + fr, cl = wc * 32 + 8 * fq;
#pragma unroll
        for (int ai = 0; ai < 2; ++ai)
#pragma unroll
            for (int m = 0; m < 4; ++m) { const int row = row0 + ai * 128 + m * 16;
                const f32x4 p0 = *(const f32x4*)(ssq0 + (size_t)row * 8), p1 = *(const f32x4*)(ssq0 + (size_t)row * 8 + 4);
                const float rstd = 1.f / sqrtf((((p0[0] + p0[1]) + (p0[2] + p0[3])) + ((p1[0] + p1[1]) + (p1[2] + p1[3]))) * (1.f / 512.f) + EPS);
#pragma unroll
                for (int bj = 0; bj < 2; ++bj) { float v[8];
#pragma unroll
                    for (int e = 0; e < 8; ++e) v[e] = acc[ai][bj][m][e >> 2][e & 3] * rstd;
                    if (pn < 4) {
                        if (wc == 0) rope_head128(v, rope32 + (size_t)row * 16 + 8 * (fq & 1), fq);
#pragma unroll
                        for (int e = 0; e < 8; ++e) v[e] *= QSCALE;
                        *(v4u*)(qa + (size_t)row * 1024 + pn * 256 + bj * 128 + cl) = pack8h(v);
                    } else {
                        if ((wc & 1) == 0) rope_head64(v, rope16 + (size_t)row * 8, fq);
                        *(v4u*)(qidx + (size_t)row * 1024 + (pn - 4) * 256 + bj * 128 + cl) = pack8(v);
                    } } }
    }
};

struct EpiPlain {
    static constexpr bool PERM = true, AFTER_DRAIN = false;
    bf16* O; int ldc;
    __device__ __forceinline__ void operator()(AccRef acc, const Unit& u, int wr, int wc, int fr, int fq) const {
        const int row0 = u.pm * 256 + wr * 64 + fr, cl = u.pn * 256 + wc * 32 + 8 * fq;
#pragma unroll
        for (int ai = 0; ai < 2; ++ai)
#pragma unroll
            for (int m = 0; m < 4; ++m) { const int row = row0 + ai * 128 + m * 16;
#pragma unroll
                for (int bj = 0; bj < 2; ++bj) { float v[8];
#pragma unroll
                    for (int e = 0; e < 8; ++e) v[e] = acc[ai][bj][m][e >> 2][e & 3];
                    *(v4u*)(O + (size_t)row * ldc + bj * 128 + cl) = pack8(v); } }
    }
};

template <bool FIRST> struct EpiMerge {
    static constexpr bool PERM = true, AFTER_DRAIN = false;
    bf16* merged; const bf16* gate;
    __device__ __forceinline__ void operator()(AccRef acc, const Unit& u, int wr, int wc, int fr, int fq) const {
        const int row0 = u.pm * 256 + wr * 64 + fr, cl = u.pn * 256 + wc * 32 + 8 * fq;
#pragma unroll
        for (int ai = 0; ai < 2; ++ai)
#pragma unroll
            for (int m = 0; m < 4; ++m) { const int row = row0 + ai * 128 + m * 16;
                v4u gg[2], pp[2];
#pragma unroll
                for (int bj = 0; bj < 2; ++bj) { const size_t off = (size_t)row * 2048 + bj * 128 + cl; gg[bj] = *(const v4u*)(gate + off); if (!FIRST) pp[bj] = *(const v4u*)(merged + off); }
#pragma unroll
                for (int bj = 0; bj < 2; ++bj) { const size_t off = (size_t)row * 2048 + bj * 128 + cl; float v[8];
                    const v4u g = gg[bj];
#pragma unroll
                    for (int e = 0; e < 4; ++e) { v[2 * e] = acc[ai][bj][m][(2 * e) >> 2][(2 * e) & 3] * bflo(g[e]); v[2 * e + 1] = acc[ai][bj][m][(2 * e + 1) >> 2][(2 * e + 1) & 3] * bfhi(g[e]); }
                    if (!FIRST) { const v4u p = pp[bj];
#pragma unroll
                        for (int e = 0; e < 4; ++e) { v[2 * e] += bflo(p[e]); v[2 * e + 1] += bfhi(p[e]); } }
                    *(v4u*)(merged + off) = pack8(v); } }
    }
};

struct EpiRes {
    static constexpr bool PERM = true, AFTER_DRAIN = false;
    const float* res; float* out; bf16* xb; float* ssq;
    __device__ __forceinline__ void operator()(AccRef acc, const Unit& u, int wr, int wc, int fr, int fq) const {
        const int row0 = u.pm * 256 + wr * 64 + fr, cl = u.pn * 256 + wc * 32 + 8 * fq;
#pragma unroll
        for (int ai = 0; ai < 2; ++ai)
#pragma unroll
            for (int m = 0; m < 4; ++m) { const int row = row0 + ai * 128 + m * 16; float ss = 0.f;
                f32x4 rr[2][2];
#pragma unroll
                for (int bj = 0; bj < 2; ++bj) { const size_t off = (size_t)row * 2048 + bj * 128 + cl; rr[bj][0] = *(const f32x4*)(res + off); rr[bj][1] = *(const f32x4*)(res + off + 4); }
#pragma unroll
                for (int bj = 0; bj < 2; ++bj) { const size_t off = (size_t)row * 2048 + bj * 128 + cl;
                    const f32x4 a0 = acc[ai][bj][m][0] + rr[bj][0], a1 = acc[ai][bj][m][1] + rr[bj][1];
                    *(f32x4*)(out + off) = a0; *(f32x4*)(out + off + 4) = a1;
                    float v[8] = {a0[0], a0[1], a0[2], a0[3], a1[0], a1[1], a1[2], a1[3]};
#pragma unroll
                    for (int e = 0; e < 8; ++e) ss += v[e] * v[e];
                    if (xb) *(v4u*)(xb + off) = pack8(v); }
                ss += __shfl_xor(ss, 16); ss += __shfl_xor(ss, 32);
                if (ssq && fq == 0) unsafeAtomicAdd(ssq + row, ss); }
    }
};

template <int ACT  > struct EpiNormed {
    static constexpr bool PERM = true, AFTER_DRAIN = false;
    bf16* O; int ldc; const float* ssq; float sc;
    __device__ __forceinline__ void operator()(AccRef acc, const Unit& u, int wr, int wc, int fr, int fq) const {
        const int row0 = u.pm * 256 + wr * 64 + fr, cl = u.pn * 256 + wc * 32 + 8 * fq;
        float sq[2][4];
#pragma unroll
        for (int ai = 0; ai < 2; ++ai)
#pragma unroll
            for (int m = 0; m < 4; ++m) sq[ai][m] = ssq[row0 + ai * 128 + m * 16];
#pragma unroll
        for (int ai = 0; ai < 2; ++ai)
#pragma unroll
            for (int m = 0; m < 4; ++m) { const int row = row0 + ai * 128 + m * 16;
                const float rs = sc / sqrtf(sq[ai][m] * (1.f / 2048.f) + EPS);
#pragma unroll
                for (int bj = 0; bj < 2; ++bj) { float v[8];
#pragma unroll
                    for (int e = 0; e < 8; ++e) { float x = acc[ai][bj][m][e >> 2][e & 3] * rs; if (ACT == 1) { x = fmaxf(x, 0.f); x = x * x; } v[e] = x; }
                    *(v4u*)(O + (size_t)row * ldc + bj * 128 + cl) = pack8(v); } }
    }
};

__device__ __forceinline__ int mapcol_in(int s) { return s < 2560 ? s : (s < 2624 ? 9728 + (s - 2560) : (s < 2640 ? 9792 + (s - 2624) : s - 80)); }
__device__ __forceinline__ void tr_item(const float* __restrict__ W, int K, int N, bf16* WT, int roff, const float* gk, int mode, LAS float* scr, int item, int lane) {
    const int nblk = (N + 31) >> 5, kb = item / nblk, nb = item - kb * nblk, k0 = 64 * kb, n0 = 32 * nb;
    const int nn = n0 + (lane & 31);
    const int nnc = nn < N ? nn : N - 1; const float* wp = W + (size_t)(k0 + (lane >> 5)) * N + nnc;
    const float gkv = gk ? gk[k0 + lane] : 1.f;
#pragma unroll
    for (int h16 = 0; h16 < 2; ++h16) {
        float wv[16];
#pragma unroll
        for (int i = 0; i < 16; ++i) wv[i] = wp[(size_t)(2 * (16 * h16 + i)) * N];
        __builtin_amdgcn_sched_barrier(0);
#pragma unroll
        for (int i = 0; i < 16; ++i) { const int kk = 2 * (16 * h16 + i) + (lane >> 5); float v = nn < N ? wv[i] : 0.f; v *= __shfl(gkv, kk); scr[kk * 33 + (lane & 31)] = v; }
    }
    LDS_WAIT();
    const int c = lane & 7;
#pragma unroll
    for (int j = 0; j < 4; ++j) { const int nl = (lane >> 3) + 8 * j, n = n0 + nl;
        if (n < N) { const LAS float* s = scr + (8 * c) * 33 + nl;
            v4u o; o.x = cvt_pk_bf16(s[0 * 33], s[1 * 33]); o.y = cvt_pk_bf16(s[2 * 33], s[3 * 33]); o.z = cvt_pk_bf16(s[4 * 33], s[5 * 33]); o.w = cvt_pk_bf16(s[6 * 33], s[7 * 33]);
            const int dr = mode ? mapcol_in(n) : n + roff;
            *(v4u*)(WT + (size_t)dr * K + k0 + 8 * c) = o; } }
    LDS_WAIT();
}
__device__ __forceinline__ void rms_row_to_bf16(const float* xrow, const float* g, bf16* orow, int lane) {
    const f32x4* xr = (const f32x4*)xrow + lane; const f32x4* gr = (const f32x4*)g + lane;
    f32x4 v[8]; float s = 0.f;
#pragma unroll
    for (int j = 0; j < 8; ++j) { v[j] = xr[64 * j]; s += (v[j].x * v[j].x + v[j].y * v[j].y) + (v[j].z * v[j].z + v[j].w * v[j].w); }
    const float rstd = 1.f / sqrtf(wave_sum(s) * (1.f / 2048.f) + EPS);
    v2u* o8 = (v2u*)orow + lane;
#pragma unroll
    for (int j = 0; j < 8; ++j) { const f32x4 gv = gr[64 * j]; v2u o; o.x = cvt_pk_bf16(v[j].x * rstd * gv.x, v[j].y * rstd * gv.y); o.y = cvt_pk_bf16(v[j].z * rstd * gv.z, v[j].w * rstd * gv.w); o8[64 * j] = o; }
}
__device__ const float ROPE_INV[16] = {1.0f, 0.44036659598350525f, 0.1939227432012558f, 0.08539710193872452f, 0.03760603070259094f, 0.01656043902039528f, 0.007292664609849453f, 0.0032114458736032248f,
    0.0014142135623842478f, 0.000622772378847003f, 0.00027424818836152554f, 0.00012076973507646471f, 5.318296098266728e-05f, 2.34199997066753e-05f, 1.0313386155758053e-05f, 4.541670477919979e-06f};
__device__ __forceinline__ f32x2 rope_cs(int pos, float inv) {
    const float ang = __fmul_rn((float)pos, inv);
    const double a = (double)ang, k = __builtin_rint(a * 0.15915494309189535), r = __builtin_fma(-k, 6.283185307179586, a);
    const float rf = (float)r; f32x2 o; o.x = __cosf(rf); o.y = __sinf(rf); return o;
}

constexpr int AK_STRIDE = 272  , AV_STRIDE = 288  , AK_OFF = 0, AV_OFF = 64 * AK_STRIDE, ABUF = AV_OFF + 64 * AV_STRIDE  , AU_OFF = 2 * ABUF;
typedef short v4i16_t __attribute__((ext_vector_type(4)));
__device__ __forceinline__ v4i16_t tr_read(LAS unsigned char* p) { return __builtin_amdgcn_ds_read_tr16_b64_v4i16((LAS v4i16_t*)p); }
template <bool MOBA>
__device__ __forceinline__ void attn_unit(LAS unsigned char* lds, const bf16* Qp, int ldq, const bf16* Kp, int ldk, const bf16* Vp, int ldv, bf16* Op, int ldo,
                                          int cur  , int s0  , const bf16* kmp  ) {
    const int tid = threadIdx.x, lane = tid & 63, wave = __builtin_amdgcn_readfirstlane(tid >> 6), fr = lane & 15, quad = lane >> 4;
    const int qrow0 = wave * 32 + fr;
    bf16x8 bq[2][4];
#pragma unroll
    for (int g = 0; g < 2; ++g)
#pragma unroll
        for (int kk = 0; kk < 4; ++kk) bq[g][kk] = *(const bf16x8*)(Qp + (size_t)(qrow0 + 16 * g) * ldq + kk * 32 + quad * 8);
    unsigned selmask[2] = {0u, 0u}, umask = 0xffffffffu;
    if (MOBA) {
        unsigned um = 0u;
#pragma unroll
        for (int g = 0; g < 2; ++g) {
            f32x4 gt[2];
#pragma unroll
            for (int mt = 0; mt < 2; ++mt) { gt[mt] = (f32x4){0.f, 0.f, 0.f, 0.f};
#pragma unroll
                for (int kk = 0; kk < 4; ++kk) { const bf16x8 a = *(const bf16x8*)(kmp + (size_t)(mt * 16 + fr) * 1024 + kk * 32 + quad * 8);
                    gt[mt] = __builtin_amdgcn_mfma_f32_16x16x32_bf16(a, bq[g][kk], gt[mt], 0, 0, 0); } }
            unsigned sm = 0u;
#pragma unroll
            for (int it = 0; it < 3; ++it) { float bv = -INFINITY; int bi = 64;
#pragma unroll
                for (int mt = 0; mt < 2; ++mt)
#pragma unroll
                    for (int r = 0; r < 4; ++r) { const int id = mt * 16 + quad * 4 + r; const float val = gt[mt][r];
                        if (id < cur && !((sm >> id) & 1u) && (val > bv || (val == bv && id < bi))) { bv = val; bi = id; } }
#pragma unroll
                for (int off = 16; off <= 32; off <<= 1) { const float ov = __shfl_xor(bv, off); const int oi = __shfl_xor(bi, off);
                    if (ov > bv || (ov == bv && oi < bi)) { bv = ov; bi = oi; } }
                if (bi < 64) sm |= 1u << bi; }
            selmask[g] = sm; um |= sm; }
#pragma unroll
        for (int off = 1; off < 16; off <<= 1) um |= (unsigned)__shfl_xor((int)um, off);
        LAS unsigned* uw = (LAS unsigned*)(lds + AU_OFF);
        __syncthreads();
        if (tid == 0) *uw = 0u;
        __syncthreads();
        if (lane == 0) atomicOr((unsigned*)uw, um);
        __syncthreads();
        umask = *uw;
    }
    f32x4 o[2][8];
#pragma unroll
    for (int g = 0; g < 2; ++g)
#pragma unroll
        for (int mt = 0; mt < 8; ++mt) o[g][mt] = (f32x4){0.f, 0.f, 0.f, 0.f};
    float m_run[2] = {-INFINITY, -INFINITY}, l_run[2] = {0.f, 0.f};
    const int ntiles = MOBA ? (cur + 1) * 4 : cur;
#define ATT_TILE_OK(t) (!MOBA || ((t) >> 2) >= cur || ((umask >> ((t) >> 2)) & 1u) != 0u)
    const int sk0 = tid >> 4, sp = tid & 15;
    const bf16* kg = Kp + (size_t)sk0 * ldk + sp * 8; const bf16* vg = Vp + (size_t)sk0 * ldv + sp * 8;
    LAS unsigned char* kl = lds + AK_OFF + sk0 * AK_STRIDE + sp * 16; LAS unsigned char* vl = lds + AV_OFF + sk0 * AV_STRIDE + sp * 16;
    int kt = 0; while (kt < ntiles && !ATT_TILE_OK(kt)) ++kt;
    v4u kr0, kr1, vr0, vr1;
    { const size_t ko = (size_t)kt * 64 * ldk, vo = (size_t)kt * 64 * ldv;
      kr0 = *(const v4u*)(kg + ko); kr1 = *(const v4u*)(kg + ko + (size_t)32 * ldk); vr0 = *(const v4u*)(vg + vo); vr1 = *(const v4u*)(vg + vo + (size_t)32 * ldv); }
    LAS unsigned char* vt = lds + AV_OFF + (4 * quad + ((lane & 15) >> 2)) * AV_STRIDE + 8 * (lane & 3);
    int par = 0;
    __syncthreads();
    *(LAS v4u*)kl = kr0; *(LAS v4u*)(kl + 32 * AK_STRIDE) = kr1; *(LAS v4u*)vl = vr0; *(LAS v4u*)(vl + 32 * AV_STRIDE) = vr1;
    int nkt = kt + 1; while (nkt < ntiles && !ATT_TILE_OK(nkt)) ++nkt;
    if (nkt < ntiles) { const size_t ko = (size_t)nkt * 64 * ldk, vo = (size_t)nkt * 64 * ldv;
        kr0 = *(const v4u*)(kg + ko); kr1 = *(const v4u*)(kg + ko + (size_t)32 * ldk); vr0 = *(const v4u*)(vg + vo); vr1 = *(const v4u*)(vg + vo + (size_t)32 * ldv); }
    __syncthreads();
    while (kt < ntiles) {
        const int blk = kt >> 2, key0 = kt * 64;
        int nnkt = ntiles;
        if (nkt < ntiles) { const int ob = (par ^ 1) * ABUF;
            *(LAS v4u*)(kl + ob) = kr0; *(LAS v4u*)(kl + ob + 32 * AK_STRIDE) = kr1; *(LAS v4u*)(vl + ob) = vr0; *(LAS v4u*)(vl + ob + 32 * AV_STRIDE) = vr1;
            nnkt = nkt + 1; while (nnkt < ntiles && !ATT_TILE_OK(nnkt)) ++nnkt;
            if (nnkt < ntiles) { const size_t ko = (size_t)nnkt * 64 * ldk, vo = (size_t)nnkt * 64 * ldv;
                kr0 = *(const v4u*)(kg + ko); kr1 = *(const v4u*)(kg + ko + (size_t)32 * ldk); vr0 = *(const v4u*)(vg + vo); vr1 = *(const v4u*)(vg + vo + (size_t)32 * ldv); } }
        LAS unsigned char* const tb = lds + par * ABUF;
        f32x4 st[2][4];
#pragma unroll
        for (int g = 0; g < 2; ++g)
#pragma unroll
            for (int mt = 0; mt < 4; ++mt) st[g][mt] = (f32x4){0.f, 0.f, 0.f, 0.f};
#pragma unroll
        for (int mt = 0; mt < 4; ++mt)
#pragma unroll
            for (int kk = 0; kk < 4; ++kk) { const bf16x8 a = *(const LAS bf16x8*)(tb + AK_OFF + (mt * 16 + fr) * AK_STRIDE + (kk * 32 + quad * 8) * 2);
                st[0][mt] = __builtin_amdgcn_mfma_f32_16x16x32_bf16(a, bq[0][kk], st[0][mt], 0, 0, 0);
                st[1][mt] = __builtin_amdgcn_mfma_f32_16x16x32_bf16(a, bq[1][kk], st[1][mt], 0, 0, 0); }
        bf16x8 pb[2][2];
#pragma unroll
        for (int g = 0; g < 2; ++g) {
            if (MOBA) {
                if (blk < cur) { if (!((selmask[g] >> blk) & 1u)) {
#pragma unroll
                        for (int mt = 0; mt < 4; ++mt) st[g][mt] = (f32x4){-INFINITY, -INFINITY, -INFINITY, -INFINITY}; } }
                else { const int qpos = s0 + qrow0 + 16 * g;
#pragma unroll
                    for (int mt = 0; mt < 4; ++mt)
#pragma unroll
                        for (int r = 0; r < 4; ++r) if (key0 + mt * 16 + quad * 4 + r > qpos) st[g][mt][r] = -INFINITY; }
            }
            float mx = -INFINITY;
#pragma unroll
            for (int mt = 0; mt < 4; ++mt)
#pragma unroll
                for (int r = 0; r < 4; ++r) mx = fmaxf(mx, st[g][mt][r]);
            mx = fmaxf(mx, __shfl_xor(mx, 16)); mx = fmaxf(mx, __shfl_xor(mx, 32));
            const float m_new = fmaxf(m_run[g], mx), m_use = (m_new == -INFINITY) ? 0.f : m_new;
            const float alpha = fexp2(m_run[g] - m_use);
            m_run[g] = m_new;
            float ps = 0.f;
#pragma unroll
            for (int mt = 0; mt < 4; ++mt)
#pragma unroll
                for (int r = 0; r < 4; ++r) { const float p = fexp2(st[g][mt][r] - m_use); st[g][mt][r] = p; ps += p; }
            l_run[g] = l_run[g] * alpha + ps;
#pragma unroll
            for (int mt = 0; mt < 8; ++mt) o[g][mt] = o[g][mt] * alpha;
#pragma unroll
            for (int ks = 0; ks < 2; ++ks) { v4u w; w.x = cvt_pk_bf16(st[g][2 * ks][0], st[g][2 * ks][1]); w.y = cvt_pk_bf16(st[g][2 * ks][2], st[g][2 * ks][3]);
                w.z = cvt_pk_bf16(st[g][2 * ks + 1][0], st[g][2 * ks + 1][1]); w.w = cvt_pk_bf16(st[g][2 * ks + 1][2], st[g][2 * ks + 1][3]); pb[g][ks] = __builtin_bit_cast(bf16x8, w); }
        }
#pragma unroll
        for (int c8 = 0; c8 < 8; ++c8)
#pragma unroll
            for (int ks = 0; ks < 2; ++ks) { const v4i16_t t0 = tr_read(vt + par * ABUF + (32 * ks) * AV_STRIDE + 32 * c8), t1 = tr_read(vt + par * ABUF + (32 * ks + 16) * AV_STRIDE + 32 * c8);
                const bf16x8 a = (bf16x8){t0[0], t0[1], t0[2], t0[3], t1[0], t1[1], t1[2], t1[3]};
                o[0][c8] = __builtin_amdgcn_mfma_f32_16x16x32_bf16(a, pb[0][ks], o[0][c8], 0, 0, 0);
                o[1][c8] = __builtin_amdgcn_mfma_f32_16x16x32_bf16(a, pb[1][ks], o[1][c8], 0, 0, 0); }
        __syncthreads();
        kt = nkt; nkt = nnkt; par ^= 1;
    }
#undef ATT_TILE_OK
#pragma unroll
    for (int g = 0; g < 2; ++g) {
        float l = l_run[g]; l += __shfl_xor(l, 16); l += __shfl_xor(l, 32);
        const float inv = 1.f / l;
#pragma unroll
        for (int mt = 0; mt < 8; ++mt) { v2u w; w.x = cvt_pk_bf16(o[g][mt][0] * inv, o[g][mt][1] * inv); w.y = cvt_pk_bf16(o[g][mt][2] * inv, o[g][mt][3] * inv);
            *(v2u*)(Op + (size_t)(qrow0 + 16 * g) * ldo + mt * 16 + quad * 4) = w; } }
    __syncthreads();
}

constexpr int DS_S_OFF = 40960, DS_SEL_OFF = DS_S_OFF + 8 * 8192, DS_P_OFF = DS_SEL_OFF + 8 * 1024;
__device__ __forceinline__ unsigned ord_key(float f) { if (f == 0.f) f = 0.f; const unsigned b = __builtin_bit_cast(unsigned, f); return b ^ ((b >> 31) ? 0xffffffffu : 0x80000000u); }

#define SEL_COUNT(cnt, OP, x) do { _Pragma("unroll") for (int c16 = 0; c16 < 8; ++c16) { if (c16 * 16 < ngq) { _Pragma("unroll") for (int i = 0; i < 16; ++i) cnt += (v[c16 * 16 + i] OP (x)) ? 1 : 0; } } } while (0)
__device__ __forceinline__ void dsa_group(LAS unsigned char* lds, int b, int t0, float* scr  , const bf16* qidx, const bf16* kidx, const float* widx,
                                          unsigned short* selg) {
    const int tid = threadIdx.x, lane = tid & 63, wave = __builtin_amdgcn_readfirstlane(tid >> 6), fr = lane & 15, quad = lane >> 4;
#ifndef DSA_NO_I
    {
        bf16x8 aq[8][2]; float wq[8][4];
#pragma unroll
        for (int q = 0; q < 8; ++q) { const size_t tok = (size_t)b * SEQ + t0 + q;
#pragma unroll
            for (int kk = 0; kk < 2; ++kk) aq[q][kk] = *(const bf16x8*)(qidx + tok * 1024 + fr * 64 + kk * 32 + quad * 8);
            const f32x4 w4 = *(const f32x4*)(widx + tok * 16 + quad * 4);
            wq[q][0] = w4[0]; wq[q][1] = w4[1]; wq[q][2] = w4[2]; wq[q][3] = w4[3]; }
        const int ng = ((t0 + 7) >> 6) + 1;
        bf16x8 bk[4][2];
        { const int g = wave < ng ? wave : 0;
#pragma unroll
          for (int cc = 0; cc < 4; ++cc) { const size_t krow = (size_t)b * SEQ + g * 64 + cc * 16 + fr;
              bk[cc][0] = *(const bf16x8*)(kidx + krow * 64 + quad * 8); bk[cc][1] = *(const bf16x8*)(kidx + krow * 64 + 32 + quad * 8); } }
        for (int g = wave; g < ng; g += 8) {
            float r[8];
#pragma unroll
            for (int q = 0; q < 8; ++q) r[q] = 0.f;
            bf16x8 cur[4][2];
#pragma unroll
            for (int cc = 0; cc < 4; ++cc) { cur[cc][0] = bk[cc][0]; cur[cc][1] = bk[cc][1]; }
            { const int gn = g + 8 < ng ? g + 8 : g;
#pragma unroll
              for (int cc = 0; cc < 4; ++cc) { const size_t krow = (size_t)b * SEQ + gn * 64 + cc * 16 + fr;
                  bk[cc][0] = *(const bf16x8*)(kidx + krow * 64 + quad * 8); bk[cc][1] = *(const bf16x8*)(kidx + krow * 64 + 32 + quad * 8); } }
#pragma unroll
            for (int q = 0; q < 8; ++q) { float sp[4];
#pragma unroll
                for (int cc = 0; cc < 4; ++cc) { f32x4 a = (f32x4){0.f, 0.f, 0.f, 0.f};
                    a = __builtin_amdgcn_mfma_f32_16x16x32_bf16(aq[q][0], cur[cc][0], a, 0, 0, 0);
                    a = __builtin_amdgcn_mfma_f32_16x16x32_bf16(aq[q][1], cur[cc][1], a, 0, 0, 0);
                    sp[cc] = wq[q][0] * fmaxf(a[0], 0.f) + wq[q][1] * fmaxf(a[1], 0.f) + wq[q][2] * fmaxf(a[2], 0.f) + wq[q][3] * fmaxf(a[3], 0.f); }
                const float m0 = (quad & 2) ? sp[2] : sp[0], m1 = (quad & 2) ? sp[3] : sp[1], s0 = (quad & 2) ? sp[0] : sp[2], s1 = (quad & 2) ? sp[1] : sp[3];
                const float t0 = m0 + __shfl_xor(s0, 32), t1 = m1 + __shfl_xor(s1, 32);
                r[q] = ((quad & 1) ? t1 : t0) + __shfl_xor((quad & 1) ? t0 : t1, 16); }
#pragma unroll
            for (int q = 0; q < 8; ++q) scr[q * 8192 + g * 64 + lane] = r[q];
        }
    }
#endif
    __syncthreads();
    const int t = t0 + wave, n = t + 1;
    LAS int* sel = (LAS int*)(lds + DS_SEL_OFF + wave * 1024);
    LAS float* Sl = (LAS float*)(lds + DS_S_OFF + wave * 8192);
    int nsel;
#ifdef DSA_NO_II
    nsel = n < 256 ? n : 256; for (int k = 0; k < 4; ++k) sel[k * 64 + lane] = k * 64 + lane;
#else
    {
        unsigned v[128];
        const int ngq = (t >> 6) + 1; const float* row = scr + wave * 8192;
#define SEL_LD(i) asm volatile("global_load_dword %0, %1, %2 offset:%3 sc0" : "=v"(v[c16 * 16 + (i)]) : "v"(voff), "s"(rp), "n"((i) * 256))
#define SEL_TIE(k) asm volatile("" : "+v"(v[(k) * 16 + 0]), "+v"(v[(k) * 16 + 1]), "+v"(v[(k) * 16 + 2]), "+v"(v[(k) * 16 + 3]), "+v"(v[(k) * 16 + 4]), "+v"(v[(k) * 16 + 5]), "+v"(v[(k) * 16 + 6]), "+v"(v[(k) * 16 + 7]), \
        "+v"(v[(k) * 16 + 8]), "+v"(v[(k) * 16 + 9]), "+v"(v[(k) * 16 + 10]), "+v"(v[(k) * 16 + 11]), "+v"(v[(k) * 16 + 12]), "+v"(v[(k) * 16 + 13]), "+v"(v[(k) * 16 + 14]), "+v"(v[(k) * 16 + 15]))
        const unsigned voff = (unsigned)lane * 4u;
#pragma unroll
        for (int c16 = 0; c16 < 8; ++c16) {
            if (c16 * 16 < ngq) { const float* rp = row + c16 * 1024;
                SEL_LD(0); SEL_LD(1); SEL_LD(2); SEL_LD(3); SEL_LD(4); SEL_LD(5); SEL_LD(6); SEL_LD(7); SEL_LD(8); SEL_LD(9); SEL_LD(10); SEL_LD(11); SEL_LD(12); SEL_LD(13); SEL_LD(14); SEL_LD(15);
            } else {
#pragma unroll
                for (int i = 0; i < 16; ++i) v[c16 * 16 + i] = 0u;
            } }
        asm volatile("s_waitcnt vmcnt(0)" ::: "memory");
        SEL_TIE(0); SEL_TIE(1); SEL_TIE(2); SEL_TIE(3); SEL_TIE(4); SEL_TIE(5); SEL_TIE(6); SEL_TIE(7);
#undef SEL_LD
#undef SEL_TIE
#pragma unroll
        for (int c16 = 0; c16 < 8; ++c16) { if (c16 * 16 < ngq) {
#pragma unroll
            for (int i = 0; i < 16; ++i) { const int ii = c16 * 16 + i; v[ii] = (ii * 64 + lane <= t) ? ord_key(__builtin_bit_cast(float, v[ii])) : 0u; } } }
        __syncthreads();
        if (n <= 256) { nsel = n;
#pragma unroll
            for (int k = 0; k < 4; ++k) sel[k * 64 + lane] = k * 64 + lane;
        } else {
            nsel = 256;
            unsigned theta = 0u; bool exact = false; int bit0 = 31;
            { unsigned vm = 0u;
#pragma unroll
              for (int c16 = 0; c16 < 8; ++c16) { if (c16 * 16 < ngq) {
#pragma unroll
                  for (int i = 0; i < 16; ++i) vm = v[c16 * 16 + i] > vm ? v[c16 * 16 + i] : vm; } }
#pragma unroll
              for (int o = 1; o < 64; o <<= 1) { const unsigned ov = (unsigned)__shfl_xor((int)vm, o); vm = ov > vm ? ov : vm; }
              const unsigned p0 = vm >> 23;
              for (unsigned k = 0; k < 4 && k <= p0; ++k) { const unsigned cand = (p0 - k) << 23; int cnt = 0;
                  SEL_COUNT(cnt, >=, cand);
                  cnt = wave_sum_i(cnt);
                  if (cnt >= 256) { theta = cand; exact = (cnt == 256); bit0 = 22; break; } } }
            if (!exact)
            for (int bit = bit0; bit >= 0; --bit) { const unsigned cand = theta | (1u << bit); int cnt = 0;
                SEL_COUNT(cnt, >=, cand);
                cnt = wave_sum_i(cnt);
                if (cnt >= 256) { theta = cand; if (cnt == 256) { exact = true; break; } } }
            const unsigned lo = exact ? theta - 1u : theta;
            int cgt = 256;
            if (!exact) { int cnt = 0;
                SEL_COUNT(cnt, >, lo);
                cgt = wave_sum_i(cnt); }
            const int need_eq = 256 - cgt;
            int base_gt = 0, base_eq = 0;
#pragma unroll
            for (int i = 0; i < 128; ++i) { if ((i & ~15) < ngq) {
                const bool gt = v[i] > lo;
                const unsigned long long mg = __ballot(gt);
                const int pg = __builtin_amdgcn_mbcnt_hi((unsigned)(mg >> 32), __builtin_amdgcn_mbcnt_lo((unsigned)mg, 0));
                if (gt) sel[base_gt + pg] = i * 64 + lane;
                base_gt += __builtin_popcountll(mg); } }
            if (need_eq > 0) {
#pragma unroll
                for (int i = 0; i < 128; ++i) { if ((i & ~15) < ngq) {
                    const bool eq = v[i] == lo;
                    const unsigned long long me = __ballot(eq);
                    const int pe = __builtin_amdgcn_mbcnt_hi((unsigned)(me >> 32), __builtin_amdgcn_mbcnt_lo((unsigned)me, 0));
                    if (eq && (base_eq + pe) < need_eq) sel[cgt + base_eq + pe] = i * 64 + lane;
                    base_eq += __builtin_popcountll(me); } } }
        }
    }
#endif
    LDS_WAIT();
    { const size_t tok = (size_t)b * SEQ + t; v2u w; w.x = (unsigned)sel[4 * lane] | ((unsigned)sel[4 * lane + 1] << 16); w.y = (unsigned)sel[4 * lane + 2] | ((unsigned)sel[4 * lane + 3] << 16);
      *(v2u*)(selg + tok * 256 + 4 * lane) = w; }
    LDS_WAIT();
}

constexpr int DA_SEL_OFF = 0, DA_S_OFF = 8 * 512;
__device__ __forceinline__ void dsa_qk_item(LAS unsigned char* lds, int wave, int lane, int b, int t, int hx, const unsigned short* selg, const bf16* qa, const bf16* ka, bf16* pg) {
    const int fr = lane & 15, quad = lane >> 4;
    LAS unsigned short* Ls = (LAS unsigned short*)(lds + DA_SEL_OFF + wave * 512);
    LAS float* Sp = (LAS float*)(lds + DA_S_OFF + wave * 1024);
    const size_t tok = (size_t)b * SEQ + t; const int nsel = t + 1 < 256 ? t + 1 : 256;
    *(LAS v2u*)(Ls + 4 * lane) = *(const v2u*)(selg + tok * 256 + 4 * lane);
    const v4u qh = *(const v4u*)(qa + tok * 1024 + hx * 128 + fr * 8);
    LDS_WAIT();
    const bf16* kbase = ka + (size_t)b * SEQ * 1024 + hx * 128 + fr * 8;
    for (int n0 = 0; n0 < 256; n0 += 64) {
        int keys[16];
#pragma unroll
        for (int u = 0; u < 16; ++u) { const int n = n0 + 4 * u + quad; keys[u] = Ls[n]; if (n >= nsel) keys[u] = 0; }
        v4u kv[16];
#pragma unroll
        for (int u = 0; u < 16; ++u) kv[u] = *(const v4u*)(kbase + (size_t)keys[u] * 1024);
        __builtin_amdgcn_sched_barrier(0);
        float d[16];
#pragma unroll
        for (int u = 0; u < 16; ++u) { float a = 0.f;
#pragma unroll
            for (int e = 0; e < 4; ++e) a = hdot2(kv[u][e], qh[e], a);
            d[u] = a; }
        float r8[8], r4[4], r2[2];
#pragma unroll
        for (int u = 0; u < 8; ++u) { const float mine = (fr & 8) ? d[u + 8] : d[u], send = (fr & 8) ? d[u] : d[u + 8]; r8[u] = mine + __shfl_xor(send, 8); }
#pragma unroll
        for (int u = 0; u < 4; ++u) { const float mine = (fr & 4) ? r8[u + 4] : r8[u], send = (fr & 4) ? r8[u] : r8[u + 4]; r4[u] = mine + __shfl_xor(send, 4); }
#pragma unroll
        for (int u = 0; u < 2; ++u) { const float mine = (fr & 2) ? r4[u + 2] : r4[u], send = (fr & 2) ? r4[u] : r4[u + 2]; r2[u] = mine + __shfl_xor(send, 2); }
        { const float mine = (fr & 1) ? r2[1] : r2[0], send = (fr & 1) ? r2[0] : r2[1]; Sp[n0 + 4 * fr + quad] = mine + __shfl_xor(send, 1); }
        __builtin_amdgcn_sched_barrier(0);
    }
    LDS_WAIT();
    f32x4 sc = *(const LAS f32x4*)(Sp + 4 * lane);
    float mx = -INFINITY;
#pragma unroll
    for (int r = 0; r < 4; ++r) { if (4 * lane + r >= nsel) sc[r] = -INFINITY; mx = fmaxf(mx, sc[r]); }
#pragma unroll
    for (int o = 1; o < 64; o <<= 1) mx = fmaxf(mx, __shfl_xor(mx, o));
    float l = 0.f;
#pragma unroll
    for (int r = 0; r < 4; ++r) { sc[r] = fexp2(sc[r] - mx); l += sc[r]; }
    l = wave_sum(l);
    const float inv = 1.f / l;
    v2u w; w.x = cvt_pk_f16(sc[0] * inv, sc[1] * inv); w.y = cvt_pk_f16(sc[2] * inv, sc[3] * inv);
    *(v2u*)(pg + (tok * 8 + hx) * 256 + 4 * lane) = w;
    LDS_WAIT();
}
__device__ __forceinline__ void dsa_pv_item(LAS unsigned char* lds, int wave, int lane, int b, int t, int hx, const unsigned short* selg, const bf16* pg, const bf16* va, bf16* odsa) {
    const int fr = lane & 15, quad = lane >> 4;
    LAS unsigned short* Ls = (LAS unsigned short*)(lds + DA_SEL_OFF + wave * 512);
    LAS unsigned short* Lp = (LAS unsigned short*)(lds + DA_S_OFF + wave * 1024);
    const size_t tok = (size_t)b * SEQ + t; const int nsel = t + 1 < 256 ? t + 1 : 256;
    *(LAS v2u*)(Ls + 4 * lane) = *(const v2u*)(selg + tok * 256 + 4 * lane);
    *(LAS v2u*)(Lp + 4 * lane) = *(const v2u*)(pg + (tok * 8 + hx) * 256 + 4 * lane);
    LDS_WAIT();
    float acc[8];
#pragma unroll
    for (int e = 0; e < 8; ++e) acc[e] = 0.f;
    const bf16* vbase = va + (size_t)b * SEQ * 1024 + hx * 128 + fr * 8;
    for (int n0 = 0; n0 < 256; n0 += 64) {
        int keys[16]; unsigned pp[8];
#pragma unroll
        for (int u = 0; u < 16; ++u) { const int n = n0 + 4 * u + quad; keys[u] = Ls[n]; if (n >= nsel) keys[u] = 0; }
#pragma unroll
        for (int u = 0; u < 8; ++u) pp[u] = (unsigned)Lp[n0 + 8 * u + quad] | ((unsigned)Lp[n0 + 8 * u + 4 + quad] << 16);
        v4u vv[16];
#pragma unroll
        for (int u = 0; u < 16; ++u) vv[u] = *(const v4u*)(vbase + (size_t)keys[u] * 1024);
        __builtin_amdgcn_sched_barrier(0);
#pragma unroll
        for (int u = 0; u < 8; ++u)
#pragma unroll
            for (int e = 0; e < 4; ++e) {
                acc[2 * e] = hdot2(__builtin_amdgcn_perm(vv[2 * u + 1][e], vv[2 * u][e], 0x05040100u), pp[u], acc[2 * e]);
                acc[2 * e + 1] = hdot2(__builtin_amdgcn_perm(vv[2 * u + 1][e], vv[2 * u][e], 0x07060302u), pp[u], acc[2 * e + 1]); }
        __builtin_amdgcn_sched_barrier(0);
    }
#pragma unroll
    for (int e = 0; e < 8; ++e) { acc[e] += __shfl_xor(acc[e], 16); acc[e] += __shfl_xor(acc[e], 32); }
    if (quad == 0) *(v4u*)(odsa + tok * 1024 + hx * 128 + fr * 8) = pack8(acc);
    LDS_WAIT();
}

#define XB_TMO      128
#define XB_XCNT(j)  (256  + 64 * (j))
#define XB_XSUB(j)  (1280 + 64 * (j))
#define XB_XGEN(j)  (2304 + 64 * (j))
#define XB_TOP      3328
#define XB_TOPGEN   3392
#define XCD_BAR_WORDS 3456
#define XB_SPIN_CAP (1u << 18)

__device__ __forceinline__ unsigned xb_ld(unsigned* p)              { return __hip_atomic_load(p, __ATOMIC_RELAXED, __HIP_MEMORY_SCOPE_AGENT); }
__device__ __forceinline__ unsigned xb_add(unsigned* p, unsigned v) { return __hip_atomic_fetch_add(p, v, __ATOMIC_RELAXED, __HIP_MEMORY_SCOPE_AGENT); }
__device__ __forceinline__ unsigned xb_xcc_id() { return (unsigned)__builtin_amdgcn_s_getreg((3 << 11) | 20) & 0xFu; }
#define XB_SPIN(cond, bar) do { unsigned _sp = 0; while (cond) { __builtin_amdgcn_s_sleep(1); \
    if ((++_sp & 255u) == 0u) { if (xb_ld(&(bar)[XB_TMO])) break; if (_sp > XB_SPIN_CAP) { atomicAdd(&(bar)[XB_TMO], 1u); break; } } } } while (0)

struct XcdBarrier {
    unsigned* bar; unsigned x;
    volatile LAS unsigned* st;
};

__device__ __forceinline__ XcdBarrier xcd_barrier_post(unsigned* bar, volatile LAS unsigned* st) {
    XcdBarrier b; b.bar = bar; b.x = xb_xcc_id(); b.st = st;
    if (threadIdx.x == 0) (void)xb_add(&bar[XB_XCNT(b.x)], 1u);
    return b;
}
__device__ __forceinline__ void xcd_barrier_complete(unsigned* bar, unsigned x, unsigned& nloc, unsigned& nx) {
    const unsigned G = gridDim.x * gridDim.y * gridDim.z;
    unsigned sum, cnt, mine, sp = 0u;
    for (;;) {
        sum = 0u; cnt = 0u; mine = 0u;
#pragma unroll
        for (unsigned j = 0; j < 16; ++j) { const unsigned c = xb_ld(&bar[XB_XCNT(j)]); sum += c; cnt += (c > 0u) ? 1u : 0u; mine = (j == x) ? c : mine; }
        if (sum == G) break;
        __builtin_amdgcn_s_sleep(1);
        if ((++sp & 255u) == 0u) { if (xb_ld(&bar[XB_TMO])) break; if (sp > XB_SPIN_CAP) { atomicAdd(&bar[XB_TMO], 1u); break; } }
    }
    nloc = mine > 0u ? mine : 1u; nx = cnt > 0u ? cnt : 1u;
}

__device__ __forceinline__ void xcd_barrier(const XcdBarrier& b) {
    asm volatile("s_waitcnt vmcnt(0)" ::: "memory");
    __syncthreads();
    if (threadIdx.x == 0) {
        unsigned* bar = b.bar;
        __builtin_amdgcn_s_waitcnt(0);
        unsigned nloc = b.st[0], nx = b.st[1];
        if (nloc == 0u) { xcd_barrier_complete(bar, b.x, nloc, nx); b.st[0] = nloc; b.st[1] = nx; }
        const unsigned old = xb_add(&bar[XB_XSUB(b.x)], 1u);
        const unsigned gen = old / nloc;
        if (old + 1u == (gen + 1u) * nloc) {
            __builtin_amdgcn_fence(__ATOMIC_RELEASE, "agent");
            asm volatile("s_waitcnt vmcnt(0)" ::: "memory");
            const unsigned og = xb_add(&bar[XB_TOP], 1u);
            const unsigned tg = og / nx;
            if (og + 1u == (tg + 1u) * nx) xb_add(&bar[XB_TOPGEN], 1u);
            else XB_SPIN(xb_ld(&bar[XB_TOPGEN]) == tg, bar);
            __builtin_amdgcn_fence(__ATOMIC_ACQUIRE, "agent");
            xb_add(&bar[XB_XGEN(b.x)], 1u);
            asm volatile("s_waitcnt vmcnt(0)" ::: "memory");
        } else {
            XB_SPIN(xb_ld(&bar[XB_XGEN(b.x)]) == gen, bar);
            __builtin_amdgcn_fence(__ATOMIC_ACQUIRE, "agent");
            asm volatile("s_waitcnt vmcnt(0)" ::: "memory");
        }
    }
    __syncthreads();
}


struct Args { const float* in[20]; const int* pos; float* out; unsigned char* ws; int ph_lo, ph_hi; };
template <class Epi>
__device__ __forceinline__ void run_gemm(LAS unsigned char* lds, const bf16* A, const bf16* Bt, int M, int N, int K, const Epi& E, int crot = 0) {
    pg8::Gemm g{A, Bt, M, N, K}; pg8::StaticOrder S; S.init(M, N, (int)gridDim.x, ((int)blockIdx.x + (int)gridDim.x - crot) % (int)gridDim.x);
    pg8::gemm_phase<Epi, pg8::StaticOrder, true, true>(lds, g, S, E);
}

__global__ void __launch_bounds__(NWAVES * 64, 2) fwd_mega(Args args) {
    extern __shared__ __attribute__((aligned(16))) unsigned char lds_raw[];
    LAS unsigned char* lds = (LAS unsigned char*)lds_raw;
    cg::grid_group grid = cg::this_grid();
    const int tid = threadIdx.x, lane = tid & 63, wave = __builtin_amdgcn_readfirstlane(tid >> 6);
    const int G = gridDim.x, c = blockIdx.x, gw = c * NWAVES + wave, NGW = G * NWAVES;
    unsigned char* ws = args.ws;
    const float* x = args.in[0]; const float* mem = args.in[1]; const int* positions = args.pos;
    float* out = args.out;
    float *ssq0 = (float*)(ws + WS_SSQ0), *ssq1 = (float*)(ws + WS_SSQ1), *ssq2 = (float*)(ws + WS_SSQ2), *ssq3 = (float*)(ws + WS_SSQ3);
    bf16* kmean = (bf16*)(ws + WS_KMEAN);
    bf16 *Wt_in = (bf16*)(ws + WS_WIN), *Wt_q = (bf16*)(ws + WS_WQ), *Wt_dsao = (bf16*)(ws + WS_WDSAO), *Wt_mobao = (bf16*)(ws + WS_WMOBAO), *Wt_out = (bf16*)(ws + WS_WOUT);
    bf16 *Wt_mq = (bf16*)(ws + WS_WMQ), *Wt_mkv = (bf16*)(ws + WS_WMKV), *Wt_mo = (bf16*)(ws + WS_WMO), *Wt_ff1 = (bf16*)(ws + WS_FF1), *Wt_ff2a = (bf16*)(ws + WS_FF2A), *Wt_ff2b = (bf16*)(ws + WS_FF2B);
    bf16 *memkv = (bf16*)(ws + WS_MEMKV), *memn = (bf16*)(ws + WS_MEMN);
    bf16 *hb = (bf16*)(ws + WS_H), *cq = (bf16*)(ws + WS_CQ), *ka = (bf16*)(ws + WS_KA), *va = (bf16*)(ws + WS_VA), *qb = (bf16*)(ws + WS_QB), *kb = (bf16*)(ws + WS_KB), *vb = (bf16*)(ws + WS_VB);
    bf16 *sga = (bf16*)(ws + WS_SGA), *sgb = (bf16*)(ws + WS_SGB); float* xres = (float*)(ws + WS_XRES);
    bf16 *kidx = (bf16*)(ws + WS_KIDX); float* widx = (float*)(ws + WS_WIDX);
    f32x2 *rope32 = (f32x2*)(ws + WS_ROPE32), *rope16 = (f32x2*)(ws + WS_ROPE16);
    bf16 *qa = (bf16*)(ws + WS_QA), *qidx = (bf16*)(ws + WS_QIDX), *odsa = (bf16*)(ws + WS_ODSA), *omoba = (bf16*)(ws + WS_OMOBA), *merged = (bf16*)(ws + WS_MERGED);
    bf16 *xb = (bf16*)(ws + WS_XB), *qm = (bf16*)(ws + WS_QM), *om = (bf16*)(ws + WS_OM), *ua = (bf16*)(ws + WS_UA);

    const int lo = args.ph_lo, hi = args.ph_hi;
#ifndef PH_MASK
#define PH_MASK 0x1FFFFF
#endif
#define IN(k) (((PH_MASK >> (k)) & 1) && lo <= (k) && (k) < hi)
    volatile LAS unsigned* xst = (volatile LAS unsigned*)(lds + LDS_BYTES - 16);
    if (tid == 0) { xst[0] = 0u; xst[1] = 0u; }
    __syncthreads();
    const XcdBarrier xbar = xcd_barrier_post((unsigned*)(ws + WS_BAR), xst);
#define GSYNC() xcd_barrier(xbar)
#define SEAM(k) do { if (IN(k) && ((k) == 3 ? IN(14) : IN((k) + 1))) { if ((k) == 0) grid.sync(); else GSYNC(); } } while (0)

#ifndef P0REPS
#define P0REPS 1
#endif
    if (IN(0)) for (int p0rep = 0; p0rep < P0REPS; ++p0rep) {
        LAS float* scr = (LAS float*)(lds + wave * 16384);
        constexpr int I_IN = 32 * 307, I_UQ = 8 * 32, I_DO = 16 * 64, I_OUT = 32 * 64, I_MQ = 32 * 16, I_MKV = 32 * 32, I_MO = 8 * 64;
        constexpr int NITEMS = I_IN + 2 * I_UQ + 2 * I_DO + I_OUT + I_MQ + I_MKV + I_MO;
        for (int it = gw; it < NITEMS; it += NGW) {
            int r = it;
            if (r < I_IN) { tr_item(args.in[4], 2048, 9808, Wt_in, 0, nullptr, 1, scr, r, lane); continue; } r -= I_IN;
            if (r < I_UQ) { tr_item(args.in[6], 512, 1024, Wt_q, 0, args.in[5], 0, scr, r, lane); continue; } r -= I_UQ;
            if (r < I_UQ) { tr_item(args.in[7], 512, 1024, Wt_q, 1024, args.in[5], 0, scr, r, lane); continue; } r -= I_UQ;
            if (r < I_DO) { tr_item(args.in[8], 1024, 2048, Wt_dsao, 0, nullptr, 0, scr, r, lane); continue; } r -= I_DO;
            if (r < I_DO) { tr_item(args.in[9], 1024, 2048, Wt_mobao, 0, nullptr, 0, scr, r, lane); continue; } r -= I_DO;
            if (r < I_OUT) { tr_item(args.in[10], 2048, 2048, Wt_out, 0, nullptr, 0, scr, r, lane); continue; } r -= I_OUT;
            if (r < I_MQ) { tr_item(args.in[13], 2048, 512, Wt_mq, 0, args.in[11], 0, scr, r, lane); continue; } r -= I_MQ;
            if (r < I_MKV) { tr_item(args.in[14], 2048, 1024, Wt_mkv, 0, nullptr, 0, scr, r, lane); continue; } r -= I_MKV;
            tr_item(args.in[15], 512, 2048, Wt_mo, 0, nullptr, 0, scr, r, lane);
        }
        for (int m = gw; m < T; m += NGW) rms_row_to_bf16(x + (size_t)m * DM, args.in[3], hb + (size_t)m * DM, lane);
        for (int m = gw; m < BATCH * 256; m += NGW) rms_row_to_bf16(mem + (size_t)m * DM, args.in[12], memn + (size_t)m * DM, lane);
        const int gt = c * 512 + tid, NGT = G * 512;
        for (int i = gt; i < T * 16; i += NGT) rope32[i] = rope_cs(positions[i >> 4], ROPE_INV[i & 15]);
        for (int i = gt; i < T * 8; i += NGT) rope16[i] = rope_cs(positions[i >> 3], ROPE_INV[2 * (i & 7)]);
        for (int i = gt; i < T; i += NGT) { ssq1[i] = 0.f; ssq2[i] = 0.f; ssq3[i] = 0.f; }
        __syncthreads();
    }
    SEAM(0);
#ifdef SYNCPROBE
    if (IN(1)) { for (int k = 0; k < 16; ++k) grid.sync(); }
#endif
#ifndef P1REPS
#define P1REPS 1
#endif
    if (IN(1)) { EpiIn E{cq, ka, va, qb, kb, vb, sga, sgb, kidx, widx, ssq0, rope32, rope16}; run_gemm(lds, hb, Wt_in, T, NIN, 2048, E);
#if P1REPS > 1
        run_gemm(lds, hb, Wt_in, T, NIN, 2048, E);
#endif
        { EpiPlain E2{memkv, 1024}; run_gemm(lds, memn, Wt_mkv, BATCH * 256, 1024, 2048, E2, G >= 256 ? 200 : 0); }
    }
    SEAM(1);
    if (IN(2)) {
        { EpiQ E{qa, qidx, ssq0, rope32, rope16}; run_gemm(lds, cq, Wt_q, T, 2048, 512, E); }
        for (int it = c; it < BATCH * 32 * 4; it += G) {
            const int blkid = it >> 2, cq4 = it & 3, cp = tid & 127, rq = tid >> 7;
            const unsigned* src = (const unsigned*)(kb + ((size_t)blkid * 256 + rq * 64) * 1024 + cq4 * 256) + cp; float s0 = 0.f, s1 = 0.f;
#pragma unroll 16
            for (int r = 0; r < 64; ++r) { const unsigned u = src[(size_t)r * 512]; s0 += bflo(u); s1 += bfhi(u); }
            LAS float* red = (LAS float*)lds;
            __syncthreads();
            red[(rq * 128 + cp) * 2] = s0; red[(rq * 128 + cp) * 2 + 1] = s1;
            __syncthreads();
            if (rq == 0) { float a0 = 0.f, a1 = 0.f;
#pragma unroll
                for (int k = 0; k < 4; ++k) { a0 += red[(k * 128 + cp) * 2]; a1 += red[(k * 128 + cp) * 2 + 1]; }
                ((unsigned*)(kmean + (size_t)blkid * 1024 + cq4 * 256))[cp] = cvt_pk_bf16(a0 * (1.f / 256.f), a1 * (1.f / 256.f)); }
        }
        __syncthreads();
    }
    SEAM(2);
    unsigned short* selg = (unsigned short*)(ws + WS_SELG);
    if (IN(3)) {
        float* scr = (float*)(ws + WS_SCR + (size_t)c * 262144);
#ifndef SELREPS
#define SELREPS 1
#endif
#ifndef MOBAREPS
#define MOBAREPS 1
#endif
#ifndef ATTREPS
#define ATTREPS 1
#endif
        for (int i = 0;; ++i) { int L = i * G + ((i & 1) ? G - 1 - c : c); if (L >= 2048 * SELREPS) break; L &= 2047;
            const int b = L & 1, t0 = (1023 - (L >> 1)) * 8;
            dsa_group(lds, b, t0, scr, qidx, kidx, widx, selg);
            __syncthreads(); }
        for (int i = 0;; ++i) { const int L = i * G + ((i & 1) ? G - 1 - c : c); if (L >= 512) break;
            const int qt = 31 - (L >> 4), bh = L & 15, b = bh >> 3, h = bh & 7, cur = qt, s0 = qt * 256;
            const size_t tok0 = (size_t)b * SEQ + s0, kb0 = (size_t)b * SEQ;
            attn_unit<true>(lds, qb + tok0 * 1024 + h * 128, 1024, kb + kb0 * 1024 + h * 128, 1024, vb + kb0 * 1024 + h * 128, 1024, omoba + tok0 * 1024 + h * 128, 1024,
                            cur, s0, kmean + (size_t)b * 32 * 1024 + h * 128); }
    }
    SEAM(3);
    if (IN(14)) {
        const int hx = c & 7, nxb = (G - hx + 7) >> 3, wx = (c >> 3) * NWAVES + wave, nwx = nxb * NWAVES;
        bf16* pg = (bf16*)(ws + WS_SCR);
        for (int b = 0; b < BATCH; ++b) {
            for (int t = wx; t < SEQ; t += nwx) dsa_qk_item(lds, wave, lane, b, t, hx, selg, qa, ka, pg);
            for (int t = wx; t < SEQ; t += nwx) dsa_pv_item(lds, wave, lane, b, t, hx, selg, pg, va, odsa);
        }
    }
    if (IN(14) && IN(4)) GSYNC();
    if (IN(4)) {
#if defined(NO_DSA)
        { EpiMerge<true> E{merged, sgb}; run_gemm(lds, omoba, Wt_mobao, T, 2048, 1024, E); }
#else
        { EpiMerge<true> E{merged, sga}; run_gemm(lds, odsa, Wt_dsao, T, 2048, 1024, E); }
#ifndef NO_MOBA
        { EpiMerge<false> E{merged, sgb}; run_gemm(lds, omoba, Wt_mobao, T, 2048, 1024, E); }
#endif
#endif
    }
    SEAM(4);
    if (IN(5)) { EpiRes E{x, xres, xb, ssq1}; run_gemm(lds, merged, Wt_out, T, 2048, 2048, E); }
    SEAM(5);
    if (IN(6)) {
        LAS float* scr = (LAS float*)(lds + wave * 16384);
        constexpr int I_F1 = 32 * 256, I_F2H = 64 * 64;
        for (int it = gw; it < I_F1 + 2 * I_F2H; it += NGW) { int r = it;
            if (r < I_F1) { tr_item(args.in[17], 2048, 8192, Wt_ff1, 0, args.in[16], 0, scr, r, lane); continue; } r -= I_F1;
            if (r < I_F2H) { tr_item(args.in[18], 4096, 2048, Wt_ff2a, 0, nullptr, 0, scr, r, lane); continue; } r -= I_F2H;
            tr_item(args.in[18] + (size_t)4096 * 2048, 4096, 2048, Wt_ff2b, 0, nullptr, 0, scr, r, lane); }
        __syncthreads();
        EpiNormed<0> E{qm, 512, ssq1, QSCALE}; run_gemm(lds, xb, Wt_mq, T, 512, 2048, E);
    }
    SEAM(6);
    if (IN(7)) {
        for (int L = c; L < 256; L += G) { const int h = L & 3, qt = L >> 2, b = qt >> 5; const size_t tok0 = (size_t)qt * 256;
            attn_unit<false>(lds, qm + tok0 * 512 + h * 128, 512, memkv + (size_t)b * 256 * 1024 + h * 128, 1024, memkv + (size_t)b * 256 * 1024 + 512 + h * 128, 1024,
                             om + tok0 * 512 + h * 128, 512, 4, 0, nullptr); }
    }
    SEAM(7);
    if (IN(8)) { EpiRes E{xres, xres, xb, ssq2}; run_gemm(lds, om, Wt_mo, T, 2048, 512, E); }
    SEAM(8);
    if (IN(9)) { EpiNormed<1> E{ua, 4096, ssq2, 1.f}; run_gemm(lds, xb, Wt_ff1, T, 4096, 2048, E); }
    SEAM(9);
    if (IN(10)) { EpiRes E{xres, xres, nullptr, nullptr}; run_gemm(lds, ua, Wt_ff2a, T, 2048, 4096, E); }
    SEAM(10);
    if (IN(11)) { EpiNormed<1> E{ua, 4096, ssq2, 1.f}; run_gemm(lds, xb, Wt_ff1 + (size_t)4096 * 2048, T, 4096, 2048, E); }
    SEAM(11);
    if (IN(12)) { EpiRes E{xres, xres, nullptr, ssq3}; run_gemm(lds, ua, Wt_ff2b, T, 2048, 4096, E); }
    SEAM(12);
    if (IN(13)) {
        const f32x4* gr = (const f32x4*)args.in[19] + lane;
        for (int m = gw; m < T; m += NGW) { const f32x4* xr = (const f32x4*)(xres + (size_t)m * DM) + lane; f32x4* orow = (f32x4*)(out + (size_t)m * DM) + lane;
            const float rstd = 1.f / sqrtf(ssq3[m] * (1.f / 2048.f) + EPS);
#pragma unroll
            for (int j = 0; j < 8; ++j) { const f32x4 v = xr[64 * j], gv = gr[64 * j]; orow[64 * j] = v * rstd * gv; } }
    }
#ifdef DUMP_PHASE
    if (IN(20)) {
        const int gt = c * 512 + tid, NGT = G * 512;
        for (size_t i = gt; i < (size_t)T * 2048; i += NGT) { const size_t m = i >> 11; const int cc = (int)(i & 2047); float v = 0.f;
#if DUMP_PHASE == 1
            if (cc < 1024) v = bflo(ka[m * 1024 + cc]) + bflo(va[m * 1024 + cc]) * 2.f + bflo(qb[m * 1024 + cc]) * 3.f + bflo(kb[m * 1024 + cc]) * 4.f + bflo(vb[m * 1024 + cc]) * 5.f;
            else v = bflo(cq[m * 512 + (cc & 511)]) + bflo(kidx[m * 64 + (cc & 63)]) * 2.f + widx[m * 16 + (cc & 15)] * 3.f + ssq0[m * 8 + (cc & 7)];
#elif DUMP_PHASE == 11
            v = bflo(sga[i]) + 2.f * bflo(sgb[i]);
#elif DUMP_PHASE == 2
            if (cc < 1024) v = bflo(qa[m * 1024 + cc]); else v = bflo(qidx[m * 1024 + cc - 1024]);
            v += bflo(kmean[i & 65535]) + bflo(memkv[i & 524287]);
#elif DUMP_PHASE == 3
            if (cc < 1024) v = bflo(odsa[m * 1024 + cc]); else v = bflo(omoba[m * 1024 + cc - 1024]);
#elif DUMP_PHASE == 4
            v = bflo(merged[i]);
#endif
            out[i] = v; }
    }
#endif
#undef IN
#undef SEAM
}

extern "C" void kernel_launch(void* const* d_in, const int* in_sizes, int n_in, void* d_out, int out_size, void* d_ws, size_t ws_size, hipStream_t stream) {
    static int grid = 0;
    if (grid == 0) {
        if (n_in != 20 || out_size != T * DM || ws_size < WS_END) { fprintf(stderr, "kernel_launch: unexpected shapes (n_in %d, out %d, ws %zu)\n", n_in, out_size, ws_size); grid = -1; return; }
        int dev = 0, cus = 0, per_cu = 0;
        (void)hipGetDevice(&dev); (void)hipDeviceGetAttribute(&cus, hipDeviceAttributeMultiprocessorCount, dev);
        if (hipFuncSetAttribute((const void*)fwd_mega, hipFuncAttributeMaxDynamicSharedMemorySize, LDS_BYTES) != hipSuccess) { fprintf(stderr, "kernel_launch: hipFuncSetAttribute failed\n"); grid = -1; return; }
        if (hipOccupancyMaxActiveBlocksPerMultiprocessor(&per_cu, (const void*)fwd_mega, NWAVES * 64, LDS_BYTES) != hipSuccess || per_cu < 1) { fprintf(stderr, "kernel_launch: occupancy query gave %d\n", per_cu); per_cu = 1; }
        (void)hipGetLastError();
        grid = cus * per_cu; if (grid > 256) grid = 256; if (grid < 1) grid = 256;
    }
    if (grid < 0) return;
    Args a{};
    for (int i = 0; i < 20; ++i) a.in[i] = (const float*)d_in[i];
    a.pos = (const int*)d_in[2]; a.out = (float*)d_out; a.ws = (unsigned char*)d_ws;
#if ONE_LAUNCH
    (void)hipMemsetAsync(d_ws, 0, 16384, stream);
    a.ph_lo = 0; a.ph_hi = 15;
    void* kargs[] = {&a};
    hipError_t e = hipLaunchCooperativeKernel((const void*)fwd_mega, dim3(grid), dim3(NWAVES * 64), kargs, LDS_BYTES, stream);
    if (e != hipSuccess) fprintf(stderr, "kernel_launch: cooperative launch failed: %s (grid %d)\n", hipGetErrorString(e), grid);
#else
#ifdef DUMP_PHASE
    for (int ph = 0; ph <= (DUMP_PHASE == 11 ? 1 : DUMP_PHASE); ++ph) { a.ph_lo = ph; a.ph_hi = ph + 1; hipLaunchKernelGGL(fwd_mega, dim3(grid), dim3(NWAVES * 64), LDS_BYTES, stream, a); }
    a.ph_lo = 20; a.ph_hi = 21; hipLaunchKernelGGL(fwd_mega, dim3(grid), dim3(NWAVES * 64), LDS_BYTES, stream, a);
#else
    for (int ph = 0; ph < NPH; ++ph) { a.ph_lo = ph; a.ph_hi = ph + 1; hipLaunchKernelGGL(fwd_mega, dim3(grid), dim3(NWAVES * 64), LDS_BYTES, stream, a); }
#endif
#endif
}
```
